# Optimizing an MI355X kernel written in HIP

```python
import jax, jax.numpy as jnp
from jax import lax
import numpy as np

D_MODEL = 1024
BATCH = 16
SEQ = 4096
DEPTH = 2

HEAD_DIM = 64
ATTN_WIDTH = D_MODEL // 2
N_Q_HEADS = ATTN_WIDTH // HEAD_DIM
N_KV_HEADS = max(N_Q_HEADS // 4, 1)
Q_PER_KV = N_Q_HEADS // N_KV_HEADS
KV_WIDTH = N_KV_HEADS * HEAD_DIM
WINDOW = 128
BLOCK = 128

CHUNK = 128
SGU_GROUP_DIM = 128
SGU_WIDTH = D_MODEL // 2
SGU_GROUPS = SGU_WIDTH // SGU_GROUP_DIM

ALPHA = (2.0 * DEPTH) ** 0.25
BETA = (8.0 * DEPTH) ** -0.25
LN_EPS = 1e-5

SPLITS = (ATTN_WIDTH, KV_WIDTH, KV_WIDTH, ATTN_WIDTH,
          SGU_WIDTH, SGU_WIDTH, SGU_WIDTH, D_MODEL, D_MODEL)
IN_COLS = sum(SPLITS)

kernel_name = "hybrid_swa_sink_sgu_gated_deepnorm"


def _layernorm(x, g, b):
    xf = x.astype(jnp.float32)
    mu = jnp.mean(xf, axis=-1, keepdims=True)
    var = jnp.mean(jnp.square(xf - mu), axis=-1, keepdims=True)
    y = (xf - mu) * lax.rsqrt(var + LN_EPS) * g.astype(jnp.float32) + b.astype(jnp.float32)
    return y.astype(x.dtype)


def _split_cols(h):
    parts, start = [], 0
    for w in SPLITS:
        parts.append(h[..., start:start + w])
        start += w
    return parts


def _swa_sinks(q, k, v, sinks):
    B, S = q.shape[0], q.shape[1]
    nb = S // BLOCK
    qb = q.reshape(B, nb, BLOCK, N_KV_HEADS, Q_PER_KV, HEAD_DIM)
    kb = k.reshape(B, nb, BLOCK, N_KV_HEADS, HEAD_DIM)
    vb = v.reshape(B, nb, BLOCK, N_KV_HEADS, HEAD_DIM)
    zpad = jnp.zeros_like(kb[:, :1])
    kk = jnp.concatenate([jnp.concatenate([zpad, kb[:, :-1]], axis=1), kb], axis=2)
    vv = jnp.concatenate([jnp.concatenate([zpad, vb[:, :-1]], axis=1), vb], axis=2)
    scale = HEAD_DIM ** -0.5
    scores = jnp.einsum('bnqhgd,bnkhd->bnhgqk', qb, kk).astype(jnp.float32) * scale
    qpos = jnp.arange(BLOCK)[:, None] + BLOCK
    kpos = jnp.arange(2 * BLOCK)[None, :]
    band = (kpos <= qpos) & (kpos > qpos - WINDOW)
    blk = jnp.arange(nb)[:, None, None]
    valid = band[None] & ((blk > 0) | (kpos[None] >= BLOCK))
    neg = jnp.finfo(jnp.float32).min
    scores = jnp.where(valid[None, :, None, None], scores, neg)
    sink = sinks.astype(jnp.float32).reshape(N_KV_HEADS, Q_PER_KV)[None, None, :, :, None, None]
    m = jnp.maximum(jnp.max(scores, axis=-1, keepdims=True), sink)
    p = jnp.exp(scores - m)
    denom = jnp.sum(p, axis=-1, keepdims=True) + jnp.exp(sink - m)
    probs = (p / denom).astype(vv.dtype)
    out = jnp.einsum('bnhgqk,bnkhd->bnqhgd', probs, vv)
    return out.reshape(B, S, ATTN_WIDTH)


def _chunked_sgu(u, v, vn_g, vn_b, w_s, b_s):
    B, S = v.shape[0], v.shape[1]
    nc = S // CHUNK
    v = _layernorm(v, vn_g, vn_b)
    vc = v.reshape(B, nc, CHUNK, SGU_GROUPS, SGU_GROUP_DIM)
    tril = jnp.tril(jnp.ones((CHUNK, CHUNK), dtype=w_s.dtype))
    w = w_s * tril[None]
    mixed = jnp.einsum('gts,bcsgd->bctgd', w, vc) + b_s.T[None, None, :, :, None]
    return u * mixed.reshape(B, S, SGU_WIDTH)


def setup_inputs(seed: int = 0) -> dict:
    key = jax.random.key(seed)
    ks = jax.random.split(key, 16)
    L, D = DEPTH, D_MODEL
    x = jax.random.normal(ks[0], (BATCH, SEQ, D), jnp.float32)
    ln_in_g = 1.0 + 0.05 * jax.random.normal(ks[1], (D,), jnp.float32)
    ln_in_b = 0.02 * jax.random.normal(ks[2], (D,), jnp.float32)
    col_scale = jnp.concatenate([
        jnp.ones((ATTN_WIDTH + KV_WIDTH,), jnp.float32),
        jnp.full((KV_WIDTH,), BETA, jnp.float32),
        jnp.ones((ATTN_WIDTH,), jnp.float32),
        jnp.full((SGU_WIDTH,), BETA, jnp.float32),
        jnp.ones((2 * SGU_WIDTH + 2 * D,), jnp.float32)])
    w_in = jax.random.normal(ks[3], (L, D, IN_COLS), jnp.float32) * (D ** -0.5) * col_scale
    b_in = 0.02 * jax.random.normal(ks[4], (L, IN_COLS), jnp.float32)
    sinks = 0.5 * jax.random.normal(ks[5], (L, N_Q_HEADS), jnp.float32)
    vn_g = 1.0 + 0.05 * jax.random.normal(ks[6], (L, SGU_WIDTH), jnp.float32)
    vn_b = 0.02 * jax.random.normal(ks[7], (L, SGU_WIDTH), jnp.float32)
    w_s = jax.random.normal(ks[8], (L, SGU_GROUPS, CHUNK, CHUNK), jnp.float32) * (CHUNK ** -0.5)
    b_s = 1.0 + 0.1 * jax.random.normal(ks[9], (L, SGU_GROUPS, CHUNK), jnp.float32)
    p_a = jax.random.normal(ks[10], (L, ATTN_WIDTH, D), jnp.float32) * (ATTN_WIDTH ** -0.5) * BETA
    p_b = jax.random.normal(ks[11], (L, SGU_WIDTH, D), jnp.float32) * (SGU_WIDTH ** -0.5) * BETA
    w_out = jax.random.normal(ks[12], (L, D, D), jnp.float32) * (D ** -0.5) * BETA
    b_out = 0.02 * jax.random.normal(ks[13], (L, D), jnp.float32)
    ln_g = 1.0 + 0.05 * jax.random.normal(ks[14], (L, D), jnp.float32)
    ln_b = 0.02 * jax.random.normal(ks[15], (L, D), jnp.float32)
    return {"x": x, "ln_in_g": ln_in_g, "ln_in_b": ln_in_b, "w_in": w_in, "b_in": b_in,
            "sinks": sinks, "vn_g": vn_g, "vn_b": vn_b, "w_s": w_s, "b_s": b_s,
            "p_a": p_a, "p_b": p_b, "w_out": w_out, "b_out": b_out,
            "ln_g": ln_g, "ln_b": ln_b}


def reference(x, ln_in_g, ln_in_b, w_in, b_in, sinks, vn_g, vn_b, w_s, b_s,
              p_a, p_b, w_out, b_out, ln_g, ln_b):
    x = _layernorm(x, ln_in_g, ln_in_b)
    for l in range(DEPTH):
        h = jnp.einsum('bsd,dc->bsc', x, w_in[l]) + b_in[l]
        q, k, v, g_a, u_b, v_b, g_b, r_a, r_b = _split_cols(h)
        y_a = _swa_sinks(q, k, v, sinks[l]) * jax.nn.silu(g_a)
        y_b = _chunked_sgu(jax.nn.gelu(u_b), jax.nn.gelu(v_b), vn_g[l], vn_b[l],
                           w_s[l], b_s[l]) * jax.nn.silu(g_b)
        merged = (jax.nn.sigmoid(r_a) * jnp.einsum('bsc,cd->bsd', y_a, p_a[l])
                  + jax.nn.sigmoid(r_b) * jnp.einsum('bsc,cd->bsd', y_b, p_b[l]))
        out = jnp.einsum('bsd,de->bse', merged, w_out[l]) + b_out[l]
        x = _layernorm(ALPHA * x + out, ln_g[l], ln_b[l])
    return x
```

```cpp
#include <hip/hip_runtime.h>
#include <hip/hip_cooperative_groups.h>
#include <cstdio>
#include <cstdint>
namespace pg8 {
#define PG8_LAS __attribute__((address_space(3)))
typedef unsigned short bf16_t;
typedef short bf16x8 __attribute__((ext_vector_type(8)));
typedef float f32x4 __attribute__((ext_vector_type(4)));
typedef unsigned u32x4 __attribute__((ext_vector_type(4)));
constexpr int BM = 256, BK = 64, HALF = 128, HTB = HALF * BK * 2  , STAGE_BYTES = 8 * HTB, NXCD = 8, WGM = 8;

__host__ __device__ __forceinline__ int lds_byte(int r, int c) { const int st = (r >> 4) * 2 + (c >> 5), rr = r & 15, cc = c & 31, ob = rr * 64 + cc * 2; return st * 1024 + (ob ^ (((ob >> 9) & 1) << 5)); }
__host__ __device__ __forceinline__ void stage_rc(int b, int& R, int& C) { const int st = b / 1024, sb = b % 1024, swz = sb ^ (((sb >> 9) & 1) << 5); R = (st >> 1) * 16 + swz / 64; C = (st & 1) * 32 + (swz % 64) / 2; }
__host__ __device__ __forceinline__ int perm32(int rho) { const int n = rho >> 4, i = rho & 15; return 8 * (i >> 2) + 4 * n + (i & 3); }

struct Unit { int pm, pn; };
struct Gemm { const bf16_t* A; const bf16_t* Bt; int M, N, K; };

struct StaticOrder {
    int nM, nN, nwg, G, c;
    __host__ __device__ void init(int M, int N, int G_, int c_) { nM = M / BM; nN = N / BM; nwg = nM * nN; G = G_; c = c_; }
    __host__ __device__ bool next(int i, Unit& u) const {
        const long L = (long)i * G + c; if (L >= nwg) return false;
        int wgid = (int)L; { const int q = nwg / NXCD, r = nwg % NXCD, xcd = wgid % NXCD, off = wgid / NXCD; wgid = (xcd < r ? xcd * (q + 1) : r * (q + 1) + (xcd - r) * q) + off; }
        const int nig = WGM * nN, gid = wgid / nig, fm = gid * WGM, gsz = (nM - fm) < WGM ? (nM - fm) : WGM;
        u.pm = fm + ((wgid % nig) % gsz); u.pn = (wgid % nig) / gsz; return true;
    }
    __device__ __forceinline__ void a_ready(const Unit&) const {}
    __device__ __forceinline__ void done(const Unit&) const {}
};

__device__ __forceinline__ unsigned cvt_pk_bf16(float lo, float hi) { unsigned r; asm volatile("v_cvt_pk_bf16_f32 %0, %1, %2" : "=v"(r) : "v"(lo), "v"(hi)); return r; }
typedef float f32x2 __attribute__((ext_vector_type(2)));
__device__ __forceinline__ float bf_lo(unsigned w) { return __uint_as_float(w << 16); }
__device__ __forceinline__ float bf_hi(unsigned w) { return __uint_as_float(w & 0xffff0000u); }
struct EpiIn {
    static constexpr bool PERM = true, AFTER_DRAIN = false;
    bf16_t* HQ; bf16_t* HR; const float* bias;
    __device__ __forceinline__ void operator()(const f32x4 (&acc)[2][2][4][2], const Unit& u, int wr, int wc, int fr, int fq) const {
        const int row0 = u.pm * BM + wr * 64 + fr, pn = u.pn;
        bf16_t* base; int ldc, colt;
        if (pn < 11) { base = HQ; ldc = 2816; colt = pn * 256; } else { base = HR; ldc = 2048; colt = (pn - 11) * 256; }
        const int act = pn < 3 ? 0 : (pn < 5 ? 1 : (pn < 9 ? 2 : (pn < 11 ? 1 : 3)));
        const float a1 = (act == 2) ? -2.302208198f : -1.442695041f;
        const float a3 = (act == 2) ? -0.1029432397f : 0.f;
        const int col0 = colt + wc * 32 + 8 * fq, bcol0 = pn * BM + wc * 32 + 8 * fq;
        f32x4 bv[2][2];
#pragma unroll
        for (int bj = 0; bj < 2; ++bj)
#pragma unroll
            for (int n = 0; n < 2; ++n) bv[bj][n] = *(const f32x4*)(bias + bcol0 + bj * HALF + 4 * n);
#pragma unroll
        for (int ai = 0; ai < 2; ++ai)
#pragma unroll
            for (int m = 0; m < 4; ++m) { bf16_t* rowp = base + (size_t)(row0 + ai * HALF + m * 16) * ldc + col0;
#pragma unroll
                for (int bj = 0; bj < 2; ++bj) { f32x4 v0 = acc[ai][bj][m][0] + bv[bj][0], v1 = acc[ai][bj][m][1] + bv[bj][1];
                    if (act != 0) {
#pragma unroll
                        for (int j = 0; j < 4; ++j) {
                            const float x0 = v0[j], x1 = v1[j];
                            const float s0 = __builtin_amdgcn_rcpf(1.0f + __builtin_amdgcn_exp2f(x0 * (a1 + a3 * x0 * x0)));
                            const float s1 = __builtin_amdgcn_rcpf(1.0f + __builtin_amdgcn_exp2f(x1 * (a1 + a3 * x1 * x1)));
                            v0[j] = (act == 3) ? s0 : x0 * s0; v1[j] = (act == 3) ? s1 : x1 * s1; } }
                    u32x4 w; w.x = cvt_pk_bf16(v0[0], v0[1]); w.y = cvt_pk_bf16(v0[2], v0[3]); w.z = cvt_pk_bf16(v1[0], v1[1]); w.w = cvt_pk_bf16(v1[2], v1[3]);
                    *(u32x4*)(rowp + bj * HALF) = w; } }
    }
};
template <int MODE> struct EpiGate {
    static constexpr bool PERM = true, AFTER_DRAIN = false;
    const bf16_t* HR; bf16_t* MG; int goff;
    __device__ __forceinline__ void operator()(const f32x4 (&acc)[2][2][4][2], const Unit& u, int wr, int wc, int fr, int fq) const {
        const int row0 = u.pm * BM + wr * 64 + fr, col0 = u.pn * BM + wc * 32 + 8 * fq;
#pragma unroll
        for (int ai = 0; ai < 2; ++ai)
#pragma unroll
            for (int m = 0; m < 4; ++m) { const size_t row = (size_t)(row0 + ai * HALF + m * 16);
#pragma unroll
                for (int bj = 0; bj < 2; ++bj) {
                    const u32x4 gw = *(const u32x4*)(HR + row * 2048 + goff + col0 + bj * HALF);
                    bf16_t* op = MG + row * 1024 + col0 + bj * HALF;
                    f32x4 v0 = acc[ai][bj][m][0], v1 = acc[ai][bj][m][1];
                    v0[0] *= bf_lo(gw.x); v0[1] *= bf_hi(gw.x); v0[2] *= bf_lo(gw.y); v0[3] *= bf_hi(gw.y);
                    v1[0] *= bf_lo(gw.z); v1[1] *= bf_hi(gw.z); v1[2] *= bf_lo(gw.w); v1[3] *= bf_hi(gw.w);
                    if (MODE == 1) { const u32x4 pw = *(const u32x4*)op;
                        v0[0] += bf_lo(pw.x); v0[1] += bf_hi(pw.x); v0[2] += bf_lo(pw.y); v0[3] += bf_hi(pw.y);
                        v1[0] += bf_lo(pw.z); v1[1] += bf_hi(pw.z); v1[2] += bf_lo(pw.w); v1[3] += bf_hi(pw.w); }
                    u32x4 w; w.x = cvt_pk_bf16(v0[0], v0[1]); w.y = cvt_pk_bf16(v0[2], v0[3]); w.z = cvt_pk_bf16(v1[0], v1[1]); w.w = cvt_pk_bf16(v1[2], v1[3]);
                    *(u32x4*)op = w; }
                asm volatile("" ::: "memory"); }
    }
};
struct EpiOut {
    static constexpr bool PERM = false, AFTER_DRAIN = false;
    float* X; const float* bias; float alpha;
    __device__ __forceinline__ void operator()(const f32x4 (&acc)[2][2][4][2], const Unit& u, int wr, int wc, int fr, int fq) const {
        const int row0 = u.pm * BM + wr * 64 + fr, col0 = u.pn * BM + wc * 32 + 4 * fq;
        f32x4 bv[2][2];
#pragma unroll
        for (int bj = 0; bj < 2; ++bj)
#pragma unroll
            for (int n = 0; n < 2; ++n) bv[bj][n] = *(const f32x4*)(bias + col0 + bj * HALF + n * 16);
#pragma unroll
        for (int ai = 0; ai < 2; ++ai)
#pragma unroll
            for (int m = 0; m < 4; ++m) { float* rowp = X + (size_t)(row0 + ai * HALF + m * 16) * 1024 + col0;
#pragma unroll
                for (int bj = 0; bj < 2; ++bj)
#pragma unroll
                    for (int n = 0; n < 2; ++n) { const f32x4 xr = *(const f32x4*)(rowp + bj * HALF + n * 16);
                        *(f32x4*)(rowp + bj * HALF + n * 16) = xr * alpha + (acc[ai][bj][m][n] + bv[bj][n]); }
                asm volatile("" ::: "memory"); }
    }
};

template <class Epi, class Sched, bool ALIGN_EPI = false, bool SP2 = false>
__device__ __forceinline__ void gemm_phase(PG8_LAS unsigned char* lds, const Gemm g, const Sched& S, const Epi& E) {
    const int tid = threadIdx.x, wid = __builtin_amdgcn_readfirstlane(tid >> 6), lane = tid & 63, wr = wid >> 2, wc = wid & 3, fr = lane & 15, fq = lane >> 4;
    const int K = g.K, nt = K / BK;
    unsigned voffA[2], voffB[2];
#pragma unroll
    for (int i = 0; i < 2; ++i) { int R, C; stage_rc(tid * 16 + i * 8192, R, C); const int Rb = Epi::PERM ? ((R & ~31) + perm32(R & 31)) : R;
        voffA[i] = (unsigned)(R * K + C) * 2u; voffB[i] = (unsigned)(Rb * K + C) * 2u; }
    const size_t kstep = (size_t)(BK * 2);
    const size_t hstep = (size_t)HALF * K * 2;
    const size_t tstep = 2 * hstep;
    const unsigned ldsw = (unsigned)wid * 1024u;
    const int aoff = lds_byte(wr * 64 + fr, fq * 8), boff = lds_byte(wc * 32 + fr, fq * 8);
#define PG8_SA(b, h) (((b) * 2 + (h)) * HTB)
#define PG8_SB(b, h) ((4 + (b) * 2 + (h)) * HTB)
#define PG8_STAGE(bufoff, gbase, voff) do { _Pragma("unroll") for (int _i = 0; _i < 2; ++_i) \
        __builtin_amdgcn_global_load_lds((const unsigned*)((const char*)(gbase) + (voff)[_i]), (PG8_LAS unsigned*)(lds + (bufoff) + ldsw + _i * 8192), 16, 0, 0); } while (0)
#define PG8_LDA(dst, b, h) do { _Pragma("unroll") for (int m = 0; m < 4; ++m) _Pragma("unroll") for (int k = 0; k < 2; ++k) dst[m][k] = *(const PG8_LAS bf16x8*)(lds + PG8_SA(b, h) + aoff + m * 2048 + k * 1024); } while (0)
#define PG8_LDB(dst, b, h) do { _Pragma("unroll") for (int n = 0; n < 2; ++n) _Pragma("unroll") for (int k = 0; k < 2; ++k) dst[n][k] = *(const PG8_LAS bf16x8*)(lds + PG8_SB(b, h) + boff + n * 2048 + k * 1024); } while (0)
#define PG8_MMA(ai, bj, At, Bt) do { __builtin_amdgcn_s_setprio(1); _Pragma("unroll") for (int m = 0; m < 4; ++m) _Pragma("unroll") for (int n = 0; n < 2; ++n) _Pragma("unroll") for (int k = 0; k < 2; ++k) \
        acc[ai][bj][m][n] = __builtin_amdgcn_mfma_f32_16x16x32_bf16(Bt[n][k], At[m][k], acc[ai][bj][m][n], 0, 0, 0); __builtin_amdgcn_s_setprio(0); } while (0)
#define PG8_WAIT_V(n) asm volatile("s_waitcnt vmcnt(" #n ")" ::: "memory")
#define PG8_WAIT_L(n) asm volatile("s_waitcnt lgkmcnt(" #n ")" ::: "memory")
#define PG8_BAR __builtin_amdgcn_s_barrier()
#define PG8_SCHED __builtin_amdgcn_sched_barrier(0)
    Unit cur, nxt; int ui = 0;
    if (!S.next(0, cur)) return;
    f32x4 acc[2][2][4][2];
#pragma unroll
    for (int a = 0; a < 2; ++a)
#pragma unroll
        for (int b = 0; b < 2; ++b)
#pragma unroll
            for (int m = 0; m < 4; ++m)
#pragma unroll
                for (int n = 0; n < 2; ++n) acc[a][b][m][n] = (f32x4){0.f, 0.f, 0.f, 0.f};
    bf16x8 At[4][2], B0[2][2], B1[2][2];
    const char* cA = (const char*)g.A + (size_t)cur.pm * tstep; const char* cB = (const char*)g.Bt + (size_t)cur.pn * tstep;
    S.a_ready(cur);
    if constexpr (SP2) {
        PG8_STAGE(PG8_SB(0, 0), cB, voffB); PG8_STAGE(PG8_SB(0, 1), cB + hstep, voffB); PG8_STAGE(PG8_SA(0, 0), cA, voffA); PG8_STAGE(PG8_SA(0, 1), cA + hstep, voffA);
        if (wr == 1) PG8_BAR;
        PG8_WAIT_V(2); PG8_BAR;
        PG8_STAGE(PG8_SB(1, 0), cB + kstep, voffB); PG8_STAGE(PG8_SA(1, 0), cA + kstep, voffA); PG8_STAGE(PG8_SB(1, 1), cB + hstep + kstep, voffB);
        PG8_WAIT_V(6); PG8_BAR;
    } else {
        PG8_STAGE(PG8_SB(0, 0), cB, voffB); PG8_STAGE(PG8_SA(0, 0), cA, voffA); PG8_STAGE(PG8_SB(0, 1), cB + hstep, voffB); PG8_STAGE(PG8_SA(0, 1), cA + hstep, voffA);
        if (wr == 1) PG8_BAR;
        PG8_WAIT_V(4); PG8_BAR;
        PG8_STAGE(PG8_SB(1, 0), cB + kstep, voffB); PG8_STAGE(PG8_SA(1, 0), cA + kstep, voffA); PG8_STAGE(PG8_SB(1, 1), cB + hstep + kstep, voffB);
        PG8_WAIT_V(6); PG8_BAR;
    }
    for (;;) {
        const bool has_next = S.next(ui + 1, nxt);
        const char* nA = has_next ? (const char*)g.A + (size_t)nxt.pm * tstep : cA; const char* nB = has_next ? (const char*)g.Bt + (size_t)nxt.pn * tstep : cB;
        for (int t = 0; t < nt; t += 2) {
            const bool last = (t == nt - 2);
            const char* a1 = cA + (size_t)(t + 1) * kstep;
            const char* a2 = last ? nA : cA + (size_t)(t + 2) * kstep; const char* b2 = last ? nB : cB + (size_t)(t + 2) * kstep;
            const char* a3 = a2 + kstep; const char* b3 = b2 + kstep;
            if (last && has_next) S.a_ready(nxt);
            if constexpr (SP2) {
            PG8_LDB(B0, 0, 0); PG8_LDB(B1, 0, 1); PG8_SCHED; PG8_LDA(At, 0, 0); PG8_STAGE(PG8_SA(1, 1), a1 + hstep, voffA);
            PG8_WAIT_V(8); PG8_WAIT_L(0); PG8_BAR; PG8_MMA(0, 0, At, B0); PG8_MMA(0, 1, At, B1); PG8_BAR; PG8_SCHED;
            PG8_LDA(At, 0, 1); PG8_STAGE(PG8_SB(0, 0), b2, voffB); PG8_STAGE(PG8_SB(0, 1), b2 + hstep, voffB); PG8_STAGE(PG8_SA(0, 0), a2, voffA);
            PG8_WAIT_V(8); PG8_WAIT_L(0); PG8_BAR; PG8_MMA(1, 0, At, B0); PG8_MMA(1, 1, At, B1); PG8_BAR; PG8_SCHED;
            PG8_LDB(B0, 1, 0); PG8_LDB(B1, 1, 1); PG8_SCHED; PG8_LDA(At, 1, 0); PG8_STAGE(PG8_SA(0, 1), a2 + hstep, voffA);
            PG8_WAIT_V(8); PG8_WAIT_L(0); PG8_BAR; PG8_MMA(0, 0, At, B0); PG8_MMA(0, 1, At, B1); PG8_BAR; PG8_SCHED;
            PG8_LDA(At, 1, 1); PG8_STAGE(PG8_SB(1, 0), b3, voffB); PG8_STAGE(PG8_SB(1, 1), b3 + hstep, voffB); PG8_STAGE(PG8_SA(1, 0), a3, voffA);
            PG8_WAIT_V(8); PG8_WAIT_L(0); PG8_BAR; PG8_MMA(1, 0, At, B0); PG8_MMA(1, 1, At, B1); PG8_BAR; PG8_SCHED;
            } else {
            PG8_LDB(B0, 0, 0); PG8_SCHED; PG8_LDA(At, 0, 0); PG8_STAGE(PG8_SA(1, 1), a1 + hstep, voffA);
            PG8_WAIT_L(8); PG8_BAR; PG8_WAIT_L(0); PG8_MMA(0, 0, At, B0); PG8_BAR; PG8_SCHED;
            PG8_LDB(B1, 0, 1); PG8_STAGE(PG8_SB(0, 0), b2, voffB);
            PG8_BAR; PG8_WAIT_L(0); PG8_MMA(0, 1, At, B1); PG8_BAR;
            PG8_LDA(At, 0, 1); PG8_STAGE(PG8_SA(0, 0), a2, voffA);
            PG8_BAR; PG8_WAIT_L(0); PG8_MMA(1, 0, At, B0); PG8_BAR; PG8_SCHED;
            PG8_STAGE(PG8_SB(0, 1), b2 + hstep, voffB);
            PG8_WAIT_V(6); PG8_BAR; PG8_MMA(1, 1, At, B1); PG8_BAR;
            PG8_LDB(B0, 1, 0); PG8_SCHED; PG8_LDA(At, 1, 0); PG8_STAGE(PG8_SA(0, 1), a2 + hstep, voffA);
            PG8_WAIT_L(8); PG8_BAR; PG8_WAIT_L(0); PG8_MMA(0, 0, At, B0); PG8_BAR; PG8_SCHED;
            PG8_LDB(B1, 1, 1); PG8_STAGE(PG8_SB(1, 0), b3, voffB);
            PG8_BAR; PG8_WAIT_L(0); PG8_MMA(0, 1, At, B1); PG8_BAR;
            PG8_LDA(At, 1, 1); PG8_STAGE(PG8_SA(1, 0), a3, voffA);
            PG8_BAR; PG8_WAIT_L(0); PG8_MMA(1, 0, At, B0); PG8_BAR; PG8_SCHED;
            PG8_STAGE(PG8_SB(1, 1), b3 + hstep, voffB);
            PG8_WAIT_V(6); PG8_BAR; PG8_MMA(1, 1, At, B1); PG8_BAR;
            }
        }
        if constexpr (ALIGN_EPI) { if (wr == 0) PG8_BAR; }
        if constexpr (!Epi::AFTER_DRAIN) { E(acc, cur, wr, wc, fr, fq); S.done(cur); }
        if (!has_next) break;
#pragma unroll
        for (int a = 0; a < 2; ++a)
#pragma unroll
            for (int b = 0; b < 2; ++b)
#pragma unroll
                for (int m = 0; m < 4; ++m)
#pragma unroll
                    for (int n = 0; n < 2; ++n) acc[a][b][m][n] = (f32x4){0.f, 0.f, 0.f, 0.f};
        cur = nxt; cA = nA; cB = nB; ++ui;
        if constexpr (ALIGN_EPI) { if (wr == 1) PG8_BAR; }
    }
    PG8_WAIT_V(0);
    if constexpr (!ALIGN_EPI) { if (wr == 0) PG8_BAR; }
    PG8_BAR;
    if constexpr (Epi::AFTER_DRAIN) { E.fused(acc, cur, wr, wc, fr, fq, lds, wid, lane); S.done(cur); }
#undef PG8_SA
#undef PG8_SB
#undef PG8_STAGE
#undef PG8_LDA
#undef PG8_LDB
#undef PG8_MMA
#undef PG8_WAIT_V
#undef PG8_WAIT_L
#undef PG8_BAR
#undef PG8_SCHED
}
}

namespace cg = cooperative_groups;
#define LAS __attribute__((address_space(3)))
typedef unsigned short bf16;
typedef short bf16x8 __attribute__((ext_vector_type(8)));
typedef short s16x4 __attribute__((ext_vector_type(4)));
typedef float f32x4 __attribute__((ext_vector_type(4)));
typedef unsigned u32x4 __attribute__((ext_vector_type(4)));
typedef unsigned u32x2 __attribute__((ext_vector_type(2)));

constexpr int D = 1024, BATCH = 16, SEQ = 4096, DEPTH = 2, M = BATCH * SEQ;
constexpr int IN_COLS = 4864, NQ = 2816, NR = 2048;
constexpr int C_K = 512, C_V = 640, C_GA = 768, C_U = 1280, C_VB = 1792, C_GB = 2304;
constexpr float LN_EPS = 1e-5f, ALPHA = 1.41421356237f;
constexpr int NWAVES = 8, NTHREADS = 512;
constexpr int LDS_BYTES = 143360;
constexpr size_t MiB = 1u << 20;
constexpr size_t WS_W = 0;
constexpr size_t W_IN_E = (size_t)IN_COLS * D, W_P_E = (size_t)D * 512, W_O_E = (size_t)D * D, W_LAYER_E = W_IN_E + 2 * W_P_E + W_O_E;
constexpr size_t WS_XB = 28 * MiB;
constexpr size_t WS_HQ = WS_XB + 128 * MiB;
constexpr size_t WS_HR = WS_HQ + 352 * MiB;
constexpr size_t WS_Y  = WS_HR + 256 * MiB;
constexpr size_t WS_MG = WS_Y + 128 * MiB;
constexpr size_t WS_END = WS_MG + 128 * MiB;
static_assert(2 * W_LAYER_E * 2 <= WS_XB, "weights fit");

__device__ __forceinline__ unsigned f2bf(float f) { unsigned u = __builtin_bit_cast(unsigned, f); return (u + 0x7fffu + ((u >> 16) & 1u)) >> 16; }
__device__ __forceinline__ unsigned pk2(float lo, float hi) { return f2bf(lo) | (f2bf(hi) << 16); }
__device__ __forceinline__ float bfl(unsigned w) { return __uint_as_float(w << 16); }
__device__ __forceinline__ float bfh(unsigned w) { return __uint_as_float(w & 0xffff0000u); }
__device__ __forceinline__ float wave_sum(float v) {
#pragma unroll
    for (int o = 1; o < 64; o <<= 1) v += __shfl_xor(v, o);
    return v;
}
__device__ __forceinline__ s16x4 tr_read(unsigned lds_addr) { s16x4 r; asm volatile("ds_read_b64_tr_b16 %0, %1\n\ts_waitcnt lgkmcnt(0)" : "=&v"(r) : "v"(lds_addr) : "memory"); return r; }
__device__ __forceinline__ unsigned lds_addr_of(const LAS void* p) { return (unsigned)(uintptr_t)p; }

__device__ __forceinline__ void transpose_item(const float* W, int K, int N, bf16* WT, LAS float* scr, int item, int lane) {
    const int nblk = N / 32, kb = item / nblk, nb = item % nblk, k0 = 64 * kb, n0 = 32 * nb;
#pragma unroll 8
    for (int i = 0; i < 32; ++i) { const int kk = 2 * i + (lane >> 5); scr[kk * 33 + (lane & 31)] = W[(size_t)(k0 + kk) * N + n0 + (lane & 31)]; }
    asm volatile("s_waitcnt lgkmcnt(0)" ::: "memory");
    const int c = lane & 7;
#pragma unroll
    for (int j = 0; j < 4; ++j) { const int n = (lane >> 3) + 8 * j; const LAS float* s = scr + (8 * c) * 33 + n;
        u32x4 o; o.x = pk2(s[0 * 33], s[1 * 33]); o.y = pk2(s[2 * 33], s[3 * 33]); o.z = pk2(s[4 * 33], s[5 * 33]); o.w = pk2(s[6 * 33], s[7 * 33]);
        *(u32x4*)(WT + (size_t)(n0 + n) * K + k0 + 8 * c) = o; }
    asm volatile("s_waitcnt lgkmcnt(0)" ::: "memory");
}
__device__ __forceinline__ void ln_row(const float* xrow, float* orow, bf16* ob, const f32x4 (&gv)[4], const f32x4 (&bv)[4], int lane) {
    const f32x4* xr = (const f32x4*)xrow + lane;
    f32x4 v[4]; float s = 0.f;
#pragma unroll
    for (int j = 0; j < 4; ++j) { v[j] = xr[64 * j]; s += (v[j].x + v[j].y) + (v[j].z + v[j].w); }
    const float mean = wave_sum(s) * (1.f / D); float s2 = 0.f;
#pragma unroll
    for (int j = 0; j < 4; ++j) { v[j] = v[j] - mean; s2 += (v[j].x * v[j].x + v[j].y * v[j].y) + (v[j].z * v[j].z + v[j].w * v[j].w); }
    const float rstd = 1.f / sqrtf(wave_sum(s2) * (1.f / D) + LN_EPS);
    f32x4* o4 = (f32x4*)orow + lane;
#pragma unroll
    for (int j = 0; j < 4; ++j) { v[j] = v[j] * rstd * gv[j] + bv[j]; o4[64 * j] = v[j]; }
    if (ob) { unsigned long long* o8 = (unsigned long long*)ob + lane;
#pragma unroll
        for (int j = 0; j < 4; ++j) o8[64 * j] = (unsigned long long)pk2(v[j].x, v[j].y) | ((unsigned long long)pk2(v[j].z, v[j].w) << 32); }
}
__device__ __forceinline__ void ln_phase(const float* src, float* dst, bf16* xb, const float* g, const float* b, int gw, int ngw, int lane) {
    f32x4 gv[4], bv[4];
#pragma unroll
    for (int j = 0; j < 4; ++j) { gv[j] = ((const f32x4*)g)[lane + 64 * j]; bv[j] = ((const f32x4*)b)[lane + 64 * j]; }
    for (int m = gw; m < M; m += ngw) ln_row(src + (size_t)m * D, dst + (size_t)m * D, xb ? xb + (size_t)m * D : nullptr, gv, bv, lane);
}

constexpr int KS_STRIDE = 72, VS_STRIDE = 80, KS_BYTES = 256 * KS_STRIDE * 2;
__device__ __forceinline__ void attn_item(LAS unsigned char* lds, const bf16* HQ, bf16* Y, const float* sinks, int item, int tid, int wave, int lane) {
    const int kvh = item & 1, bn = item >> 1, nblk = bn & 31;
    const long tok0 = (long)bn * 128;
    LAS bf16* Ks = (LAS bf16*)lds; LAS bf16* Vs = (LAS bf16*)(lds + KS_BYTES);
#pragma unroll
    for (int i = 0; i < 4; ++i) { const int idx = tid + 512 * i, row = idx >> 3, ch = idx & 7;
        const bool ok = (nblk > 0) || (row >= 128);
        const long tr = ok ? (tok0 - 128 + row) : tok0;
        const bf16* src = HQ + (size_t)tr * NQ + C_K + kvh * 64 + ch * 8;
        u32x4 kv = *(const u32x4*)src, vv = *(const u32x4*)(src + 128);
        if (!ok) { kv = (u32x4){0u, 0u, 0u, 0u}; vv = kv; }
        *(LAS u32x4*)(Ks + row * KS_STRIDE + ch * 8) = kv; *(LAS u32x4*)(Vs + row * VS_STRIDE + ch * 8) = vv; }
    __syncthreads();
    const int r = lane & 15, G = lane >> 4, g = wave & 3, hq = kvh * 4 + g;
    const float L2E = 1.4426950409f, SC = 0.125f * L2E;
    const float sink2 = sinks[hq] * L2E;
    for (int pi = 0; pi < 4; ++pi) {
        const int qt = (wave >> 2) + 2 * pi, i0 = qt * 16;
        const size_t tokq = (size_t)(tok0 + i0 + r);
        bf16x8 qf[2];
#pragma unroll
        for (int ks = 0; ks < 2; ++ks) qf[ks] = *(const bf16x8*)(HQ + tokq * NQ + hq * 64 + 32 * ks + 8 * G);
        f32x4 S[9];
#pragma unroll
        for (int kt = 0; kt < 9; ++kt) { f32x4 a = (f32x4){0.f, 0.f, 0.f, 0.f};
#pragma unroll
            for (int ks = 0; ks < 2; ++ks) { const bf16x8 kf = *(const LAS bf16x8*)(Ks + (i0 + kt * 16 + r) * KS_STRIDE + 32 * ks + 8 * G);
                a = __builtin_amdgcn_mfma_f32_16x16x32_bf16(kf, qf[ks], a, 0, 0, 0); }
            S[kt] = a; }
        float mx = -3.0e38f;
#pragma unroll
        for (int kt = 0; kt < 9; ++kt) { const bool dead = (nblk == 0) && (i0 + 16 * kt < 128);
#pragma unroll
            for (int i = 0; i < 4; ++i) { float t = S[kt][i] * SC;
                if (kt == 0) t = (4 * G + i > r) ? t : -3.0e38f;
                if (kt == 8) t = (4 * G + i <= r) ? t : -3.0e38f;
                t = dead ? -3.0e38f : t; S[kt][i] = t; mx = fmaxf(mx, t); } }
        mx = fmaxf(mx, __shfl_xor(mx, 16)); mx = fmaxf(mx, __shfl_xor(mx, 32));
        const float mm = fmaxf(mx, sink2); float sum = 0.f;
#pragma unroll
        for (int kt = 0; kt < 9; ++kt)
#pragma unroll
            for (int i = 0; i < 4; ++i) { const float p = __builtin_amdgcn_exp2f(S[kt][i] - mm); S[kt][i] = p; sum += p; }
        sum += __shfl_xor(sum, 16); sum += __shfl_xor(sum, 32);
        const float inv = 1.0f / (sum + __builtin_amdgcn_exp2f(sink2 - mm));
        bf16x8 pf[5];
#pragma unroll
        for (int kk = 0; kk < 4; ++kk) { u32x4 w; w.x = pk2(S[2 * kk][0], S[2 * kk][1]); w.y = pk2(S[2 * kk][2], S[2 * kk][3]); w.z = pk2(S[2 * kk + 1][0], S[2 * kk + 1][1]); w.w = pk2(S[2 * kk + 1][2], S[2 * kk + 1][3]);
            pf[kk] = __builtin_bit_cast(bf16x8, w); }
        { u32x4 w; w.x = pk2(S[8][0], S[8][1]); w.y = pk2(S[8][2], S[8][3]); w.z = 0u; w.w = 0u; pf[4] = __builtin_bit_cast(bf16x8, w); }
        const unsigned vbase = lds_addr_of(Vs) + (unsigned)(((i0 + 4 * G + (r >> 2)) * VS_STRIDE + 4 * (r & 3)) * 2);
#pragma unroll
        for (int dt = 0; dt < 4; ++dt) { f32x4 o = (f32x4){0.f, 0.f, 0.f, 0.f};
#pragma unroll
            for (int kk = 0; kk < 5; ++kk) { const unsigned a0 = vbase + (unsigned)((32 * kk * VS_STRIDE + dt * 16) * 2);
                const s16x4 lo = tr_read(a0); s16x4 hi = (s16x4){0, 0, 0, 0}; if (kk < 4) hi = tr_read(a0 + 16 * VS_STRIDE * 2);
                const bf16x8 vf = (bf16x8){lo[0], lo[1], lo[2], lo[3], hi[0], hi[1], hi[2], hi[3]};
                o = __builtin_amdgcn_mfma_f32_16x16x32_bf16(vf, pf[kk], o, 0, 0, 0); }
            const int col = hq * 64 + dt * 16 + 4 * G;
            const u32x2 ga = *(const u32x2*)(HQ + tokq * NQ + C_GA + col);
            u32x2 w; w.x = pk2(o[0] * inv * bfl(ga.x), o[1] * inv * bfh(ga.x)); w.y = pk2(o[2] * inv * bfl(ga.y), o[3] * inv * bfh(ga.y));
            *(u32x2*)(Y + tokq * 512 + col) = w; }
    }
    __syncthreads();
}

constexpr int VN_STRIDE = 528;
__device__ __forceinline__ void sgu_item(LAS unsigned char* lds, const bf16* HQ, bf16* Y, const float* vn_g, const float* vn_b, const float* w_s, const float* b_s, int bn, int wave, int lane) {
    const size_t tok0 = (size_t)bn * 128;
    LAS bf16* Vn = (LAS bf16*)lds;
    {
        float gam[8], bet[8];
#pragma unroll
        for (int j = 0; j < 8; ++j) { gam[j] = vn_g[lane * 8 + j]; bet[j] = vn_b[lane * 8 + j]; }
#pragma unroll 4
        for (int i = 0; i < 16; ++i) { const int s = wave * 16 + i;
            const u32x4 w = *(const u32x4*)(HQ + (tok0 + s) * NQ + C_VB + lane * 8);
            float v[8] = {bfl(w.x), bfh(w.x), bfl(w.y), bfh(w.y), bfl(w.z), bfh(w.z), bfl(w.w), bfh(w.w)};
            float sm = ((v[0] + v[1]) + (v[2] + v[3])) + ((v[4] + v[5]) + (v[6] + v[7]));
            const float mean = wave_sum(sm) * (1.f / 512.f); float q = 0.f;
#pragma unroll
            for (int j = 0; j < 8; ++j) { v[j] -= mean; q += v[j] * v[j]; }
            const float rstd = 1.f / sqrtf(wave_sum(q) * (1.f / 512.f) + LN_EPS);
#pragma unroll
            for (int j = 0; j < 8; ++j) v[j] = v[j] * rstd * gam[j] + bet[j];
            u32x4 o; o.x = pk2(v[0], v[1]); o.y = pk2(v[2], v[3]); o.z = pk2(v[4], v[5]); o.w = pk2(v[6], v[7]);
            *(LAS u32x4*)(Vn + s * VN_STRIDE + lane * 8) = o; }
    }
    __syncthreads();
    const int r = lane & 15, G = lane >> 4, p = wave & 3, dh = wave >> 2;
    const unsigned nbase = lds_addr_of(Vn) + (unsigned)(((4 * G + (r >> 2)) * VN_STRIDE + 4 * (r & 3)) * 2);
    for (int g = 0; g < 4; ++g) {
#pragma unroll
        for (int half = 0; half < 2; ++half) { const int tt = half ? 7 - p : p, nks = (tt >> 1) + 1, t = tt * 16 + r;
            bf16x8 wf[4];
            const float* wrow = w_s + ((size_t)g * 128 + t) * 128;
#pragma unroll
            for (int ks = 0; ks < 4; ++ks) { if (ks < nks) { const int s0 = 32 * ks + 4 * G; f32x4 a = *(const f32x4*)(wrow + s0), b = *(const f32x4*)(wrow + s0 + 16);
                    if (ks == nks - 1) {
#pragma unroll
                        for (int j = 0; j < 4; ++j) { a[j] = (s0 + j <= t) ? a[j] : 0.f; b[j] = (s0 + 16 + j <= t) ? b[j] : 0.f; } }
                    u32x4 w; w.x = pk2(a[0], a[1]); w.y = pk2(a[2], a[3]); w.z = pk2(b[0], b[1]); w.w = pk2(b[2], b[3]);
                    wf[ks] = __builtin_bit_cast(bf16x8, w); } else wf[ks] = (bf16x8){0, 0, 0, 0, 0, 0, 0, 0}; }
            const float bs = b_s[g * 128 + t];
            const size_t tok = tok0 + t;
#pragma unroll
            for (int di = 0; di < 4; ++di) { const int dtile = dh * 4 + di; f32x4 c = (f32x4){0.f, 0.f, 0.f, 0.f};
#pragma unroll
                for (int ks = 0; ks < 4; ++ks) { if (ks < nks) { const unsigned a0 = nbase + (unsigned)((32 * ks * VN_STRIDE + g * 128 + dtile * 16) * 2);
                        const s16x4 lo = tr_read(a0), hi = tr_read(a0 + 16 * VN_STRIDE * 2);
                        const bf16x8 vf = (bf16x8){lo[0], lo[1], lo[2], lo[3], hi[0], hi[1], hi[2], hi[3]};
                        c = __builtin_amdgcn_mfma_f32_16x16x32_bf16(vf, wf[ks], c, 0, 0, 0); } }
                const int col = g * 128 + dtile * 16 + 4 * G;
                const u32x2 uu = *(const u32x2*)(HQ + tok * NQ + C_U + col), gb = *(const u32x2*)(HQ + tok * NQ + C_GB + col);
                u32x2 w; w.x = pk2(bfl(uu.x) * (c[0] + bs) * bfl(gb.x), bfh(uu.x) * (c[1] + bs) * bfh(gb.x)); w.y = pk2(bfl(uu.y) * (c[2] + bs) * bfl(gb.y), bfh(uu.y) * (c[3] + bs) * bfh(gb.y));
                *(u32x2*)(Y + tok * 512 + col) = w; }
        }
    }
    __syncthreads();
}

struct Args { const float* in[16]; float* out; unsigned char* ws; };
typedef __attribute__((address_space(4))) const Args* KArgs;
#define PHASE_ENV() KArgs ka = (KArgs)__builtin_amdgcn_kernarg_segment_ptr(); asm volatile("" : "+s"(ka)); \
    int tid = threadIdx.x; asm volatile("" : "+v"(tid)); const int lane = tid & 63, wave = __builtin_amdgcn_readfirstlane(tid >> 6); \
    const int G = gridDim.x, bx = blockIdx.x; unsigned char* ws = ka->ws; (void)lane; (void)wave; (void)G; (void)bx; (void)ws

__device__ __forceinline__ void phase_prologue(LAS unsigned char* lds) {
    PHASE_ENV();
    const int gw = bx * NWAVES + wave, ngw = G * NWAVES;
    bf16* WT = (bf16*)(ws + WS_W);
    LAS float* scr = (LAS float*)(lds + wave * 16384);
    constexpr int I_IN = (D / 64) * (IN_COLS / 32), I_P = (512 / 64) * (D / 32), I_O = (D / 64) * (D / 32), I_L = I_IN + 2 * I_P + I_O;
    for (int it = gw; it < DEPTH * I_L; it += ngw) {
        const int l = it / I_L; int rr = it % I_L; bf16* wl = WT + (size_t)l * W_LAYER_E;
        if (rr < I_IN) { transpose_item(ka->in[3] + (size_t)l * D * IN_COLS, D, IN_COLS, wl, scr, rr, lane); continue; } rr -= I_IN;
        if (rr < I_P) { transpose_item(ka->in[10] + (size_t)l * 512 * D, 512, D, wl + W_IN_E, scr, rr, lane); continue; } rr -= I_P;
        if (rr < I_P) { transpose_item(ka->in[11] + (size_t)l * 512 * D, 512, D, wl + W_IN_E + W_P_E, scr, rr, lane); continue; } rr -= I_P;
        transpose_item(ka->in[12] + (size_t)l * D * D, D, D, wl + W_IN_E + 2 * W_P_E, scr, rr, lane);
    }
    ln_phase(ka->in[0], ka->out, (bf16*)(ws + WS_XB), ka->in[1], ka->in[2], gw, ngw, lane);
}
__device__ __forceinline__ void phase_inproj(LAS unsigned char* lds, int l) {
    PHASE_ENV();
    pg8::Gemm g{(const bf16*)(ws + WS_XB), (const bf16*)(ws + WS_W) + (size_t)l * W_LAYER_E, M, IN_COLS, D}; pg8::StaticOrder S; S.init(M, IN_COLS, G, bx);
    pg8::EpiIn E{(bf16*)(ws + WS_HQ), (bf16*)(ws + WS_HR), ka->in[4] + (size_t)l * IN_COLS};
    pg8::gemm_phase<pg8::EpiIn, pg8::StaticOrder, true, true>(lds, g, S, E);
}
__device__ __forceinline__ void phase_mixers(LAS unsigned char* lds, int l) {
    PHASE_ENV();
    const bf16* HQ = (const bf16*)(ws + WS_HQ); bf16* YA = (bf16*)(ws + WS_Y); bf16* YB = YA + (size_t)M * 512;
    { const float* sinks = ka->in[5] + l * 8;
      for (int it = bx; it < BATCH * 32 * 2; it += G) attn_item(lds, HQ, YA, sinks, it, tid, wave, lane); }
    { const float* vn_g = ka->in[6] + l * 512; const float* vn_b = ka->in[7] + l * 512; const float* w_s = ka->in[8] + (size_t)l * 4 * 128 * 128; const float* b_s = ka->in[9] + l * 512;
      for (int it = bx; it < BATCH * 32; it += G) sgu_item(lds, HQ, YB, vn_g, vn_b, w_s, b_s, it, wave, lane); }
}
template <int MODE> __device__ __forceinline__ void phase_gate(LAS unsigned char* lds, int l) {
    PHASE_ENV();
    const bf16* YA = (const bf16*)(ws + WS_Y);
    pg8::Gemm g{YA + (size_t)MODE * M * 512, (const bf16*)(ws + WS_W) + (size_t)l * W_LAYER_E + W_IN_E + (size_t)MODE * W_P_E, M, D, 512}; pg8::StaticOrder S; S.init(M, D, G, bx);
    pg8::EpiGate<MODE> E{(const bf16*)(ws + WS_HR), (bf16*)(ws + WS_MG), MODE * 1024};
    pg8::gemm_phase<pg8::EpiGate<MODE>, pg8::StaticOrder, true, true>(lds, g, S, E);
}
__device__ __forceinline__ void phase_outproj(LAS unsigned char* lds, int l) {
    PHASE_ENV();
    pg8::Gemm g{(const bf16*)(ws + WS_MG), (const bf16*)(ws + WS_W) + (size_t)l * W_LAYER_E + W_IN_E + 2 * W_P_E, M, D, D}; pg8::StaticOrder S; S.init(M, D, G, bx);
    pg8::EpiOut E{ka->out, ka->in[13] + (size_t)l * D, ALPHA};
    pg8::gemm_phase<pg8::EpiOut, pg8::StaticOrder, true, true>(lds, g, S, E);
}
__device__ __forceinline__ void phase_ln(int l) {
    PHASE_ENV();
    const int gw = bx * NWAVES + wave, ngw = G * NWAVES;
    ln_phase(ka->out, ka->out, (l + 1 < DEPTH) ? (bf16*)(ws + WS_XB) : nullptr, ka->in[14] + (size_t)l * D, ka->in[15] + (size_t)l * D, gw, ngw, lane);
}

__global__ void __launch_bounds__(NTHREADS, 2) fwd_megakernel(Args args) {
    extern __shared__ __attribute__((aligned(16))) unsigned char lds_raw[];
    LAS unsigned char* lds = (LAS unsigned char*)lds_raw;
    cg::grid_group grid = cg::this_grid();
    phase_prologue(lds); __syncthreads();
    grid.sync();
#pragma unroll
    for (int l = 0; l < DEPTH; ++l) {
        phase_inproj(lds, l);        grid.sync();
        phase_mixers(lds, l);        grid.sync();
        phase_gate<0>(lds, l);
        phase_gate<1>(lds, l);       grid.sync();
        phase_outproj(lds, l);       grid.sync();
        phase_ln(l);
        if (l + 1 < DEPTH) grid.sync();
    }
}

extern "C" void kernel_launch(void* const* d_in, const int* in_sizes, int n_in, void* d_out, int out_size, void* d_ws, size_t ws_size, hipStream_t stream) {
    static int grid = 0;
    if (grid == 0) {
        if (n_in != 16 || in_sizes[0] != M * D || out_size != M * D || ws_size < WS_END) { fprintf(stderr, "kernel_launch: unexpected shapes (n_in %d, in0 %d, out %d, ws %zu)\n", n_in, n_in > 0 ? in_sizes[0] : -1, out_size, ws_size); grid = -1; return; }
        int dev = 0, cus = 0, per_cu = 0;
        hipGetDevice(&dev); hipDeviceGetAttribute(&cus, hipDeviceAttributeMultiprocessorCount, dev);
        if (hipFuncSetAttribute((const void*)fwd_megakernel, hipFuncAttributeMaxDynamicSharedMemorySize, LDS_BYTES) != hipSuccess) { fprintf(stderr, "kernel_launch: hipFuncSetAttribute failed\n"); grid = -1; return; }
        if (hipOccupancyMaxActiveBlocksPerMultiprocessor(&per_cu, (const void*)fwd_megakernel, NTHREADS, LDS_BYTES) != hipSuccess || per_cu < 1) { fprintf(stderr, "kernel_launch: occupancy query says %d\n", per_cu); per_cu = 1; }
        (void)hipGetLastError();
        grid = cus * 1;
        if (grid <= 0) grid = 256;
    }
    if (grid < 0) return;
    Args a{};
    for (int i = 0; i < 16; ++i) a.in[i] = (const float*)d_in[i];
    a.out = (float*)d_out; a.ws = (unsigned char*)d_ws;
    void* kargs[] = {&a};
    hipError_t e = hipLaunchCooperativeKernel((const void*)fwd_megakernel, dim3(grid), dim3(NTHREADS), kargs, LDS_BYTES, stream);
    if (e != hipSuccess) fprintf(stderr, "kernel_launch: cooperative launch failed: %s (grid %d)\n", hipGetErrorString(e), grid);
}
```

```cpp
#include <hip/hip_runtime.h>
#include <hip/hip_cooperative_groups.h>
#include <cstdio>
#include <cstdint>
namespace pg8 {
#define PG8_LAS __attribute__((address_space(3)))
typedef unsigned short bf16_t;
typedef short bf16x8 __attribute__((ext_vector_type(8)));
typedef float f32x4 __attribute__((ext_vector_type(4)));
typedef unsigned u32x4 __attribute__((ext_vector_type(4)));
constexpr int BM = 256, BK = 64, HALF = 128, HTB = HALF * BK * 2  , STAGE_BYTES = 8 * HTB, NXCD = 8, WGM = 8;

__host__ __device__ __forceinline__ int lds_byte(int r, int c) { const int st = (r >> 4) * 2 + (c >> 5), rr = r & 15, cc = c & 31, ob = rr * 64 + cc * 2; return st * 1024 + (ob ^ (((ob >> 9) & 1) << 5)); }
__host__ __device__ __forceinline__ void stage_rc(int b, int& R, int& C) { const int st = b / 1024, sb = b % 1024, swz = sb ^ (((sb >> 9) & 1) << 5); R = (st >> 1) * 16 + swz / 64; C = (st & 1) * 32 + (swz % 64) / 2; }
__host__ __device__ __forceinline__ int perm32(int rho) { const int n = rho >> 4, i = rho & 15; return 8 * (i >> 2) + 4 * n + (i & 3); }

struct Unit { int pm, pn; };
struct Gemm { const bf16_t* A; const bf16_t* Bt; int M, N, K; };

struct StaticOrder {
    int nM, nN, nwg, G, c;
    __host__ __device__ void init(int M, int N, int G_, int c_) { nM = M / BM; nN = N / BM; nwg = nM * nN; G = G_; c = c_; }
    __host__ __device__ bool next(int i, Unit& u) const {
        const long L = (long)i * G + c; if (L >= nwg) return false;
        int wgid = (int)L; { const int q = nwg / NXCD, r = nwg % NXCD, xcd = wgid % NXCD, off = wgid / NXCD; wgid = (xcd < r ? xcd * (q + 1) : r * (q + 1) + (xcd - r) * q) + off; }
        const int nig = WGM * nN, gid = wgid / nig, fm = gid * WGM, gsz = (nM - fm) < WGM ? (nM - fm) : WGM;
        u.pm = fm + ((wgid % nig) % gsz); u.pn = (wgid % nig) / gsz; return true;
    }
    __device__ __forceinline__ void a_ready(const Unit&) const {}
    __device__ __forceinline__ void done(const Unit&) const {}
};

__device__ __forceinline__ unsigned cvt_pk_bf16(float lo, float hi) { unsigned r; asm volatile("v_cvt_pk_bf16_f32 %0, %1, %2" : "=v"(r) : "v"(lo), "v"(hi)); return r; }
typedef float f32x2 __attribute__((ext_vector_type(2)));
__device__ __forceinline__ float bf_lo(unsigned w) { return __uint_as_float(w << 16); }
__device__ __forceinline__ float bf_hi(unsigned w) { return __uint_as_float(w & 0xffff0000u); }
struct EpiIn {
    static constexpr bool PERM = true, AFTER_DRAIN = false;
    bf16_t* HQ; bf16_t* HR; const float* bias;
    __device__ __forceinline__ void operator()(const f32x4 (&acc)[2][2][4][2], const Unit& u, int wr, int wc, int fr, int fq) const {
        const int row0 = u.pm * BM + wr * 64 + fr, pn = u.pn;
        bf16_t* base; int ldc, colt;
        if (pn < 11) { base = HQ; ldc = 2816; colt = pn * 256; } else { base = HR; ldc = 2048; colt = (pn - 11) * 256; }
        const int act = pn < 3 ? 0 : (pn < 5 ? 1 : (pn < 9 ? 2 : (pn < 11 ? 1 : 3)));
        const float a1 = (act == 2) ? -2.302208198f : -1.442695041f;
        const float a3 = (act == 2) ? -0.1029432397f : 0.f;
        const int col0 = colt + wc * 32 + 8 * fq, bcol0 = pn * BM + wc * 32 + 8 * fq;
        f32x4 bv[2][2];
#pragma unroll
        for (int bj = 0; bj < 2; ++bj)
#pragma unroll
            for (int n = 0; n < 2; ++n) bv[bj][n] = *(const f32x4*)(bias + bcol0 + bj * HALF + 4 * n);
#pragma unroll
        for (int ai = 0; ai < 2; ++ai)
#pragma unroll
            for (int m = 0; m < 4; ++m) { bf16_t* rowp = base + (size_t)(row0 + ai * HALF + m * 16) * ldc + col0;
#pragma unroll
                for (int bj = 0; bj < 2; ++bj) { f32x4 v0 = acc[ai][bj][m][0] + bv[bj][0], v1 = acc[ai][bj][m][1] + bv[bj][1];
                    if (act != 0) {
#pragma unroll
                        for (int j = 0; j < 4; ++j) {
                            const float x0 = v0[j], x1 = v1[j];
                            const float s0 = __builtin_amdgcn_rcpf(1.0f + __builtin_amdgcn_exp2f(x0 * (a1 + a3 * x0 * x0)));
                            const float s1 = __builtin_amdgcn_rcpf(1.0f + __builtin_amdgcn_exp2f(x1 * (a1 + a3 * x1 * x1)));
                            v0[j] = (act == 3) ? s0 : x0 * s0; v1[j] = (act == 3) ? s1 : x1 * s1; } }
                    u32x4 w; w.x = cvt_pk_bf16(v0[0], v0[1]); w.y = cvt_pk_bf16(v0[2], v0[3]); w.z = cvt_pk_bf16(v1[0], v1[1]); w.w = cvt_pk_bf16(v1[2], v1[3]);
                    *(u32x4*)(rowp + bj * HALF) = w; } }
    }
};
template <int MODE> struct EpiGate {
    static constexpr bool PERM = true, AFTER_DRAIN = false;
    const bf16_t* HR; bf16_t* MG; int goff;
    __device__ __forceinline__ void operator()(const f32x4 (&acc)[2][2][4][2], const Unit& u, int wr, int wc, int fr, int fq) const {
        const int row0 = u.pm * BM + wr * 64 + fr, col0 = u.pn * BM + wc * 32 + 8 * fq;
#pragma unroll
        for (int ai = 0; ai < 2; ++ai)
#pragma unroll
            for (int m = 0; m < 4; ++m) { const size_t row = (size_t)(row0 + ai * HALF + m * 16);
#pragma unroll
                for (int bj = 0; bj < 2; ++bj) {
                    const u32x4 gw = *(const u32x4*)(HR + row * 2048 + goff + col0 + bj * HALF);
                    bf16_t* op = MG + row * 1024 + col0 + bj * HALF;
                    f32x4 v0 = acc[ai][bj][m][0], v1 = acc[ai][bj][m][1];
                    v0[0] *= bf_lo(gw.x); v0[1] *= bf_hi(gw.x); v0[2] *= bf_lo(gw.y); v0[3] *= bf_hi(gw.y);
                    v1[0] *= bf_lo(gw.z); v1[1] *= bf_hi(gw.z); v1[2] *= bf_lo(gw.w); v1[3] *= bf_hi(gw.w);
                    if (MODE == 1) { const u32x4 pw = *(const u32x4*)op;
                        v0[0] += bf_lo(pw.x); v0[1] += bf_hi(pw.x); v0[2] += bf_lo(pw.y); v0[3] += bf_hi(pw.y);
                        v1[0] += bf_lo(pw.z); v1[1] += bf_hi(pw.z); v1[2] += bf_lo(pw.w); v1[3] += bf_hi(pw.w); }
                    u32x4 w; w.x = cvt_pk_bf16(v0[0], v0[1]); w.y = cvt_pk_bf16(v0[2], v0[3]); w.z = cvt_pk_bf16(v1[0], v1[1]); w.w = cvt_pk_bf16(v1[2], v1[3]);
                    *(u32x4*)op = w; }
                asm volatile("" ::: "memory"); }
    }
};
struct EpiOut {
    static constexpr bool PERM = false, AFTER_DRAIN = false;
    float* X; const float* bias; float alpha;
    __device__ __forceinline__ void operator()(const f32x4 (&acc)[2][2][4][2], const Unit& u, int wr, int wc, int fr, int fq) const {
        const int row0 = u.pm * BM + wr * 64 + fr, col0 = u.pn * BM + wc * 32 + 4 * fq;
        f32x4 bv[2][2];
#pragma unroll
        for (int bj = 0; bj < 2; ++bj)
#pragma unroll
            for (int n = 0; n < 2; ++n) bv[bj][n] = *(const f32x4*)(bias + col0 + bj * HALF + n * 16);
#pragma unroll
        for (int ai = 0; ai < 2; ++ai)
#pragma unroll
            for (int m = 0; m < 4; ++m) { float* rowp = X + (size_t)(row0 + ai * HALF + m * 16) * 1024 + col0;
#pragma unroll
                for (int bj = 0; bj < 2; ++bj)
#pragma unroll
                    for (int n = 0; n < 2; ++n) { const f32x4 xr = *(const f32x4*)(rowp + bj * HALF + n * 16);
                        *(f32x4*)(rowp + bj * HALF + n * 16) = xr * alpha + (acc[ai][bj][m][n] + bv[bj][n]); }
                asm volatile("" ::: "memory"); }
    }
};

template <class Epi, class Sched, bool ALIGN_EPI = false, bool SP2 = false>
__device__ __forceinline__ void gemm_phase(PG8_LAS unsigned char* lds, const Gemm g, const Sched& S, const Epi& E) {
    const int tid = threadIdx.x, wid = __builtin_amdgcn_readfirstlane(tid >> 6), lane = tid & 63, wr = wid >> 2, wc = wid & 3, fr = lane & 15, fq = lane >> 4;
    const int K = g.K, nt = K / BK;
    unsigned voffA[2], voffB[2];
#pragma unroll
    for (int i = 0; i < 2; ++i) { int R, C; stage_rc(tid * 16 + i * 8192, R, C); const int Rb = Epi::PERM ? ((R & ~31) + perm32(R & 31)) : R;
        voffA[i] = (unsigned)(R * K + C) * 2u; voffB[i] = (unsigned)(Rb * K + C) * 2u; }
    const size_t kstep = (size_t)(BK * 2);
    const size_t hstep = (size_t)HALF * K * 2;
    const size_t tstep = 2 * hstep;
    const unsigned ldsw = (unsigned)wid * 1024u;
    const int aoff = lds_byte(wr * 64 + fr, fq * 8), boff = lds_byte(wc * 32 + fr, fq * 8);
#define PG8_SA(b, h) (((b) * 2 + (h)) * HTB)
#define PG8_SB(b, h) ((4 + (b) * 2 + (h)) * HTB)
#define PG8_STAGE(bufoff, gbase, voff) do { _Pragma("unroll") for (int _i = 0; _i < 2; ++_i) \
        __builtin_amdgcn_global_load_lds((const unsigned*)((const char*)(gbase) + (voff)[_i]), (PG8_LAS unsigned*)(lds + (bufoff) + ldsw + _i * 8192), 16, 0, 0); } while (0)
#define PG8_LDA(dst, b, h) do { _Pragma("unroll") for (int m = 0; m < 4; ++m) _Pragma("unroll") for (int k = 0; k < 2; ++k) dst[m][k] = *(const PG8_LAS bf16x8*)(lds + PG8_SA(b, h) + aoff + m * 2048 + k * 1024); } while (0)
#define PG8_LDB(dst, b, h) do { _Pragma("unroll") for (int n = 0; n < 2; ++n) _Pragma("unroll") for (int k = 0; k < 2; ++k) dst[n][k] = *(const PG8_LAS bf16x8*)(lds + PG8_SB(b, h) + boff + n * 2048 + k * 1024); } while (0)
#define PG8_MMA(ai, bj, At, Bt) do { __builtin_amdgcn_s_setprio(1); _Pragma("unroll") for (int m = 0; m < 4; ++m) _Pragma("unroll") for (int n = 0; n < 2; ++n) _Pragma("unroll") for (int k = 0; k < 2; ++k) \
        acc[ai][bj][m][n] = __builtin_amdgcn_mfma_f32_16x16x32_bf16(Bt[n][k], At[m][k], acc[ai][bj][m][n], 0, 0, 0); __builtin_amdgcn_s_setprio(0); } while (0)
#define PG8_WAIT_V(n) asm volatile("s_waitcnt vmcnt(" #n ")" ::: "memory")
#define PG8_WAIT_L(n) asm volatile("s_waitcnt lgkmcnt(" #n ")" ::: "memory")
#define PG8_BAR __builtin_amdgcn_s_barrier()
#define PG8_SCHED __builtin_amdgcn_sched_barrier(0)
    Unit cur, nxt; int ui = 0;
    if (!S.next(0, cur)) return;
    f32x4 acc[2][2][4][2];
#pragma unroll
    for (int a = 0; a < 2; ++a)
#pragma unroll
        for (int b = 0; b < 2; ++b)
#pragma unroll
            for (int m = 0; m < 4; ++m)
#pragma unroll
                for (int n = 0; n < 2; ++n) acc[a][b][m][n] = (f32x4){0.f, 0.f, 0.f, 0.f};
    bf16x8 At[4][2], B0[2][2], B1[2][2];
    const char* cA = (const char*)g.A + (size_t)cur.pm * tstep; const char* cB = (const char*)g.Bt + (size_t)cur.pn * tstep;
    S.a_ready(cur);
    if constexpr (SP2) {
        PG8_STAGE(PG8_SB(0, 0), cB, voffB); PG8_STAGE(PG8_SB(0, 1), cB + hstep, voffB); PG8_STAGE(PG8_SA(0, 0), cA, voffA); PG8_STAGE(PG8_SA(0, 1), cA + hstep, voffA);
        if (wr == 1) PG8_BAR;
        PG8_WAIT_V(2); PG8_BAR;
        PG8_STAGE(PG8_SB(1, 0), cB + kstep, voffB); PG8_STAGE(PG8_SA(1, 0), cA + kstep, voffA); PG8_STAGE(PG8_SB(1, 1), cB + hstep + kstep, voffB);
        PG8_WAIT_V(6); PG8_BAR;
    } else {
        PG8_STAGE(PG8_SB(0, 0), cB, voffB); PG8_STAGE(PG8_SA(0, 0), cA, voffA); PG8_STAGE(PG8_SB(0, 1), cB + hstep, voffB); PG8_STAGE(PG8_SA(0, 1), cA + hstep, voffA);
        if (wr == 1) PG8_BAR;
        PG8_WAIT_V(4); PG8_BAR;
        PG8_STAGE(PG8_SB(1, 0), cB + kstep, voffB); PG8_STAGE(PG8_SA(1, 0), cA + kstep, voffA); PG8_STAGE(PG8_SB(1, 1), cB + hstep + kstep, voffB);
        PG8_WAIT_V(6); PG8_BAR;
    }
    for (;;) {
        const bool has_next = S.next(ui + 1, nxt);
        const char* nA = has_next ? (const char*)g.A + (size_t)nxt.pm * tstep : cA; const char* nB = has_next ? (const char*)g.Bt + (size_t)nxt.pn * tstep : cB;
        for (int t = 0; t < nt; t += 2) {
            const bool last = (t == nt - 2);
            const char* a1 = cA + (size_t)(t + 1) * kstep;
            const char* a2 = last ? nA : cA + (size_t)(t + 2) * kstep; const char* b2 = last ? nB : cB + (size_t)(t + 2) * kstep;
            const char* a3 = a2 + kstep; const char* b3 = b2 + kstep;
            if (last && has_next) S.a_ready(nxt);
            if constexpr (SP2) {
            PG8_LDB(B0, 0, 0); PG8_LDB(B1, 0, 1); PG8_SCHED; PG8_LDA(At, 0, 0); PG8_STAGE(PG8_SA(1, 1), a1 + hstep, voffA);
            PG8_WAIT_V(8); PG8_WAIT_L(0); PG8_BAR; PG8_MMA(0, 0, At, B0); PG8_MMA(0, 1, At, B1); PG8_BAR; PG8_SCHED;
            PG8_LDA(At, 0, 1); PG8_STAGE(PG8_SB(0, 0), b2, voffB); PG8_STAGE(PG8_SB(0, 1), b2 + hstep, voffB); PG8_STAGE(PG8_SA(0, 0), a2, voffA);
            PG8_WAIT_V(8); PG8_WAIT_L(0); PG8_BAR; PG8_MMA(1, 0, At, B0); PG8_MMA(1, 1, At, B1); PG8_BAR; PG8_SCHED;
            PG8_LDB(B0, 1, 0); PG8_LDB(B1, 1, 1); PG8_SCHED; PG8_LDA(At, 1, 0); PG8_STAGE(PG8_SA(0, 1), a2 + hstep, voffA);
            PG8_WAIT_V(8); PG8_WAIT_L(0); PG8_BAR; PG8_MMA(0, 0, At, B0); PG8_MMA(0, 1, At, B1); PG8_BAR; PG8_SCHED;
            PG8_LDA(At, 1, 1); PG8_STAGE(PG8_SB(1, 0), b3, voffB); PG8_STAGE(PG8_SB(1, 1), b3 + hstep, voffB); PG8_STAGE(PG8_SA(1, 0), a3, voffA);
            PG8_WAIT_V(8); PG8_WAIT_L(0); PG8_BAR; PG8_MMA(1, 0, At, B0); PG8_MMA(1, 1, At, B1); PG8_BAR; PG8_SCHED;
            } else {
            PG8_LDB(B0, 0, 0); PG8_SCHED; PG8_LDA(At, 0, 0); PG8_STAGE(PG8_SA(1, 1), a1 + hstep, voffA);
            PG8_WAIT_L(8); PG8_BAR; PG8_WAIT_L(0); PG8_MMA(0, 0, At, B0); PG8_BAR; PG8_SCHED;
            PG8_LDB(B1, 0, 1); PG8_STAGE(PG8_SB(0, 0), b2, voffB);
            PG8_BAR; PG8_WAIT_L(0); PG8_MMA(0, 1, At, B1); PG8_BAR;
            PG8_LDA(At, 0, 1); PG8_STAGE(PG8_SA(0, 0), a2, voffA);
            PG8_BAR; PG8_WAIT_L(0); PG8_MMA(1, 0, At, B0); PG8_BAR; PG8_SCHED;
            PG8_STAGE(PG8_SB(0, 1), b2 + hstep, voffB);
            PG8_WAIT_V(6); PG8_BAR; PG8_MMA(1, 1, At, B1); PG8_BAR;
            PG8_LDB(B0, 1, 0); PG8_SCHED; PG8_LDA(At, 1, 0); PG8_STAGE(PG8_SA(0, 1), a2 + hstep, voffA);
            PG8_WAIT_L(8); PG8_BAR; PG8_WAIT_L(0); PG8_MMA(0, 0, At, B0); PG8_BAR; PG8_SCHED;
            PG8_LDB(B1, 1, 1); PG8_STAGE(PG8_SB(1, 0), b3, voffB);
            PG8_BAR; PG8_WAIT_L(0); PG8_MMA(0, 1, At, B1); PG8_BAR;
            PG8_LDA(At, 1, 1); PG8_STAGE(PG8_SA(1, 0), a3, voffA);
            PG8_BAR; PG8_WAIT_L(0); PG8_MMA(1, 0, At, B0); PG8_BAR; PG8_SCHED;
            PG8_STAGE(PG8_SB(1, 1), b3 + hstep, voffB);
            PG8_WAIT_V(6); PG8_BAR; PG8_MMA(1, 1, At, B1); PG8_BAR;
            }
        }
        if constexpr (ALIGN_EPI) { if (wr == 0) PG8_BAR; }
        if constexpr (!Epi::AFTER_DRAIN) { E(acc, cur, wr, wc, fr, fq); S.done(cur); }
        if (!has_next) break;
#pragma unroll
        for (int a = 0; a < 2; ++a)
#pragma unroll
            for (int b = 0; b < 2; ++b)
#pragma unroll
                for (int m = 0; m < 4; ++m)
#pragma unroll
                    for (int n = 0; n < 2; ++n) acc[a][b][m][n] = (f32x4){0.f, 0.f, 0.f, 0.f};
        cur = nxt; cA = nA; cB = nB; ++ui;
        if constexpr (ALIGN_EPI) { if (wr == 1) PG8_BAR; }
    }
    PG8_WAIT_V(0);
    if constexpr (!ALIGN_EPI) { if (wr == 0) PG8_BAR; }
    PG8_BAR;
    if constexpr (Epi::AFTER_DRAIN) { E.fused(acc, cur, wr, wc, fr, fq, lds, wid, lane); S.done(cur); }
#undef PG8_SA
#undef PG8_SB
#undef PG8_STAGE
#undef PG8_LDA
#undef PG8_LDB
#undef PG8_MMA
#undef PG8_WAIT_V
#undef PG8_WAIT_L
#undef PG8_BAR
#undef PG8_SCHED
}
}

namespace cg = cooperative_groups;
#define LAS __attribute__((address_space(3)))
typedef unsigned short bf16;
typedef short bf16x8 __attribute__((ext_vector_type(8)));
typedef short s16x4 __attribute__((ext_vector_type(4)));
typedef float f32x4 __attribute__((ext_vector_type(4)));
typedef unsigned u32x4 __attribute__((ext_vector_type(4)));
typedef unsigned u32x2 __attribute__((ext_vector_type(2)));

constexpr int D = 1024, BATCH = 16, SEQ = 4096, DEPTH = 2, M = BATCH * SEQ;
constexpr int IN_COLS = 4864, NQ = 2816, NR = 2048;
constexpr int C_K = 512, C_V = 640, C_GA = 768, C_U = 1280, C_VB = 1792, C_GB = 2304;
constexpr float LN_EPS = 1e-5f, ALPHA = 1.41421356237f;
constexpr int NWAVES = 8, NTHREADS = 512;
constexpr int LDS_BYTES = 143360;
constexpr size_t MiB = 1u << 20;
constexpr size_t WS_W = 0;
constexpr size_t W_IN_E = (size_t)IN_COLS * D, W_P_E = (size_t)D * 512, W_O_E = (size_t)D * D, W_LAYER_E = W_IN_E + 2 * W_P_E + W_O_E;
constexpr size_t WS_XB = 28 * MiB;
constexpr size_t WS_HQ = WS_XB + 128 * MiB;
constexpr size_t WS_HR = WS_HQ + 352 * MiB;
constexpr size_t WS_Y  = WS_HR + 256 * MiB;
constexpr size_t WS_MG = WS_Y + 128 * MiB;
constexpr size_t WS_END = WS_MG + 128 * MiB;
constexpr size_t WS_CTL = WS_END + 65536, CTL_BYTES = 16384;
constexpr int XBAR_LDS_OFF = LDS_BYTES - 64;
static_assert(2 * W_LAYER_E * 2 <= WS_XB, "weights fit");

__device__ __forceinline__ unsigned f2bf(float f) { unsigned u = __builtin_bit_cast(unsigned, f); return (u + 0x7fffu + ((u >> 16) & 1u)) >> 16; }
__device__ __forceinline__ unsigned pk2(float lo, float hi) { return f2bf(lo) | (f2bf(hi) << 16); }
__device__ __forceinline__ float bfl(unsigned w) { return __uint_as_float(w << 16); }
__device__ __forceinline__ float bfh(unsigned w) { return __uint_as_float(w & 0xffff0000u); }
__device__ __forceinline__ float wave_sum(float v) {
#pragma unroll
    for (int o = 1; o < 64; o <<= 1) v += __shfl_xor(v, o);
    return v;
}
__device__ __forceinline__ s16x4 tr_read(unsigned lds_addr) { s16x4 r; asm volatile("ds_read_b64_tr_b16 %0, %1\n\ts_waitcnt lgkmcnt(0)" : "=&v"(r) : "v"(lds_addr) : "memory"); return r; }
__device__ __forceinline__ unsigned lds_addr_of(const LAS void* p) { return (unsigned)(uintptr_t)p; }

#define XB_TMO      128
#define XB_XCNT(j)  (256  + 64 * (j))
#define XB_XSUB(j)  (1280 + 64 * (j))
#define XB_XGEN(j)  (2304 + 64 * (j))
#define XB_TOP      3328
#define XB_TOPGEN   3392
#define XCD_BAR_WORDS 3456
#define XB_SPIN_CAP (1u << 18)

__device__ __forceinline__ unsigned xb_ld(unsigned* p)              { return __hip_atomic_load(p, __ATOMIC_RELAXED, __HIP_MEMORY_SCOPE_AGENT); }
__device__ __forceinline__ unsigned xb_add(unsigned* p, unsigned v) { return __hip_atomic_fetch_add(p, v, __ATOMIC_RELAXED, __HIP_MEMORY_SCOPE_AGENT); }
__device__ __forceinline__ unsigned xb_xcc_id() { return (unsigned)__builtin_amdgcn_s_getreg((3 << 11) | 20) & 0xFu; }
#define XB_SPIN(cond, bar) do { unsigned _sp = 0; while (cond) { __builtin_amdgcn_s_sleep(1); \
    if ((++_sp & 255u) == 0u) { if (xb_ld(&(bar)[XB_TMO])) break; if (_sp > XB_SPIN_CAP) { atomicAdd(&(bar)[XB_TMO], 1u); break; } } } } while (0)

struct XcdBarrier {
    unsigned* bar; unsigned x;
    volatile LAS unsigned* st;
};

__device__ __forceinline__ XcdBarrier xcd_barrier_post(unsigned* bar, volatile LAS unsigned* st) {
    XcdBarrier b; b.bar = bar; b.x = xb_xcc_id(); b.st = st;
    if (threadIdx.x == 0) (void)xb_add(&bar[XB_XCNT(b.x)], 1u);
    return b;
}
__device__ __forceinline__ void xcd_barrier_complete(unsigned* bar, unsigned x, unsigned& nloc, unsigned& nx) {
    const unsigned G = gridDim.x * gridDim.y * gridDim.z;
    unsigned sum, cnt, mine, sp = 0u;
    for (;;) {
        sum = 0u; cnt = 0u; mine = 0u;
#pragma unroll
        for (unsigned j = 0; j < 16; ++j) { const unsigned c = xb_ld(&bar[XB_XCNT(j)]); sum += c; cnt += (c > 0u) ? 1u : 0u; mine = (j == x) ? c : mine; }
        if (sum == G) break;
        __builtin_amdgcn_s_sleep(1);
        if ((++sp & 255u) == 0u) { if (xb_ld(&bar[XB_TMO])) break; if (sp > XB_SPIN_CAP) { atomicAdd(&bar[XB_TMO], 1u); break; } }
    }
    nloc = mine > 0u ? mine : 1u; nx = cnt > 0u ? cnt : 1u;
}

__device__ __forceinline__ void xcd_barrier(const XcdBarrier& b) {
    asm volatile("s_waitcnt vmcnt(0)" ::: "memory");
    __syncthreads();
    if (threadIdx.x == 0) {
        unsigned* bar = b.bar;
        __builtin_amdgcn_s_waitcnt(0);
        unsigned nloc = b.st[0], nx = b.st[1];
        if (nloc == 0u) { xcd_barrier_complete(bar, b.x, nloc, nx); b.st[0] = nloc; b.st[1] = nx; }
        const unsigned old = xb_add(&bar[XB_XSUB(b.x)], 1u);
        const unsigned gen = old / nloc;
        if (old + 1u == (gen + 1u) * nloc) {
            __builtin_amdgcn_fence(__ATOMIC_RELEASE, "agent");
            asm volatile("s_waitcnt vmcnt(0)" ::: "memory");
            const unsigned og = xb_add(&bar[XB_TOP], 1u);
            const unsigned tg = og / nx;
            if (og + 1u == (tg + 1u) * nx) xb_add(&bar[XB_TOPGEN], 1u);
            else XB_SPIN(xb_ld(&bar[XB_TOPGEN]) == tg, bar);
            __builtin_amdgcn_fence(__ATOMIC_ACQUIRE, "agent");
            xb_add(&bar[XB_XGEN(b.x)], 1u);
            asm volatile("s_waitcnt vmcnt(0)" ::: "memory");
        } else {
            XB_SPIN(xb_ld(&bar[XB_XGEN(b.x)]) == gen, bar);
            __builtin_amdgcn_fence(__ATOMIC_ACQUIRE, "agent");
            asm volatile("s_waitcnt vmcnt(0)" ::: "memory");
        }
    }
    __syncthreads();
}

__device__ __forceinline__ void transpose_item(const float* W, int K, int N, bf16* WT, LAS float* scr, int item, int lane) {
    const int nblk = N / 32, kb = item / nblk, nb = item % nblk, k0 = 64 * kb, n0 = 32 * nb;
#pragma unroll 8
    for (int i = 0; i < 32; ++i) { const int kk = 2 * i + (lane >> 5); scr[kk * 33 + (lane & 31)] = W[(size_t)(k0 + kk) * N + n0 + (lane & 31)]; }
    asm volatile("s_waitcnt lgkmcnt(0)" ::: "memory");
    const int c = lane & 7;
#pragma unroll
    for (int j = 0; j < 4; ++j) { const int n = (lane >> 3) + 8 * j; const LAS float* s = scr + (8 * c) * 33 + n;
        u32x4 o; o.x = pk2(s[0 * 33], s[1 * 33]); o.y = pk2(s[2 * 33], s[3 * 33]); o.z = pk2(s[4 * 33], s[5 * 33]); o.w = pk2(s[6 * 33], s[7 * 33]);
        *(u32x4*)(WT + (size_t)(n0 + n) * K + k0 + 8 * c) = o; }
    asm volatile("s_waitcnt lgkmcnt(0)" ::: "memory");
}
template <int NR> __device__ __forceinline__ void ln_rows(const float* src, float* dst, bf16* xb, int m0, int mstride, const f32x4 (&gv)[4], const f32x4 (&bv)[4], int lane) {
    f32x4 v[NR][4]; float s[NR];
#pragma unroll
    for (int q = 0; q < NR; ++q) { const f32x4* xr = (const f32x4*)(src + (size_t)(m0 + q * mstride) * D) + lane;
#pragma unroll
        for (int j = 0; j < 4; ++j) v[q][j] = xr[64 * j]; }
#pragma unroll
    for (int q = 0; q < NR; ++q) { s[q] = 0.f;
#pragma unroll
        for (int j = 0; j < 4; ++j) s[q] += (v[q][j].x + v[q][j].y) + (v[q][j].z + v[q][j].w); }
#pragma unroll
    for (int o = 1; o < 64; o <<= 1)
#pragma unroll
        for (int q = 0; q < NR; ++q) s[q] += __shfl_xor(s[q], o);
    float s2[NR];
#pragma unroll
    for (int q = 0; q < NR; ++q) { const float mean = s[q] * (1.f / D); s2[q] = 0.f;
#pragma unroll
        for (int j = 0; j < 4; ++j) { v[q][j] = v[q][j] - mean; s2[q] += (v[q][j].x * v[q][j].x + v[q][j].y * v[q][j].y) + (v[q][j].z * v[q][j].z + v[q][j].w * v[q][j].w); } }
#pragma unroll
    for (int o = 1; o < 64; o <<= 1)
#pragma unroll
        for (int q = 0; q < NR; ++q) s2[q] += __shfl_xor(s2[q], o);
#pragma unroll
    for (int q = 0; q < NR; ++q) { const float rstd = 1.f / sqrtf(s2[q] * (1.f / D) + LN_EPS); const size_t ro = (size_t)(m0 + q * mstride) * D;
        f32x4* o4 = (f32x4*)(dst + ro) + lane;
#pragma unroll
        for (int j = 0; j < 4; ++j) { v[q][j] = v[q][j] * rstd * gv[j] + bv[j]; o4[64 * j] = v[q][j]; }
        if (xb) { unsigned long long* o8 = (unsigned long long*)(xb + ro) + lane;
#pragma unroll
            for (int j = 0; j < 4; ++j) o8[64 * j] = (unsigned long long)pk2(v[q][j].x, v[q][j].y) | ((unsigned long long)pk2(v[q][j].z, v[q][j].w) << 32); } }
}
__device__ __forceinline__ void ln_phase(const float* src, float* dst, bf16* xb, const float* g, const float* b, int gw, int ngw, int lane) {
    f32x4 gv[4], bv[4];
#pragma unroll
    for (int j = 0; j < 4; ++j) { gv[j] = ((const f32x4*)g)[lane + 64 * j]; bv[j] = ((const f32x4*)b)[lane + 64 * j]; }
    constexpr int NR = 4;
    int m = gw;
    for (; m + (NR - 1) * ngw < M; m += NR * ngw) ln_rows<NR>(src, dst, xb, m, ngw, gv, bv, lane);
    for (; m < M; m += ngw) ln_rows<1>(src, dst, xb, m, ngw, gv, bv, lane);
}

constexpr int KS_STRIDE = 72, VS_STRIDE = 80, KS_BYTES = 256 * KS_STRIDE * 2;
__device__ __forceinline__ s16x4 tr_read_nw(unsigned lds_addr) { s16x4 r; asm volatile("ds_read_b64_tr_b16 %0, %1" : "=&v"(r) : "v"(lds_addr)); return r; }
#define TR_WAIT_FIRST(x) asm volatile("s_waitcnt lgkmcnt(0)" : "+v"(x))
#define TR_DEP(x) asm volatile("" : "+v"(x))
struct KVRegs { u32x4 k[4], v[4]; };
__device__ __forceinline__ void attn_load_kv(KVRegs& R, const bf16* __restrict__ HQ, int item, int tid) {
    const int kvh = item & 1, bn = item >> 1, nblk = bn & 31; const long tok0 = (long)bn * 128;
#pragma unroll
    for (int i = 0; i < 4; ++i) { const int idx = tid + 512 * i, row = idx >> 3, ch = idx & 7;
        const long tr = ((nblk > 0) || (row >= 128)) ? (tok0 - 128 + row) : tok0;
        const bf16* src = HQ + (size_t)tr * NQ + C_K + kvh * 64 + ch * 8;
        R.k[i] = *(const u32x4*)src; R.v[i] = *(const u32x4*)(src + 128); }
}
__device__ __forceinline__ void attn_phase(LAS unsigned char* lds, const bf16* __restrict__ HQ, bf16* __restrict__ Y, const float* __restrict__ sinks, int bx, int G, int tid, int wave, int lane) {
    constexpr int NITEMS = BATCH * 32 * 2;
    LAS bf16* Ks = (LAS bf16*)lds; LAS bf16* Vs = (LAS bf16*)(lds + KS_BYTES);
    const int r = lane & 15, Gq = lane >> 4, g = wave & 3;
    const float L2E = 1.4426950409f, SC = 0.125f * L2E;
    KVRegs R;
    int item = bx;
    if (item < NITEMS) attn_load_kv(R, HQ, item, tid);
    for (; item < NITEMS; item += G) {
        const int kvh = item & 1, bn = item >> 1, nblk = bn & 31, hq = kvh * 4 + g; const long tok0 = (long)bn * 128;
#pragma unroll
        for (int i = 0; i < 4; ++i) { const int idx = tid + 512 * i, row = idx >> 3, ch = idx & 7;
            *(LAS u32x4*)(Ks + row * KS_STRIDE + ch * 8) = R.k[i]; *(LAS u32x4*)(Vs + row * VS_STRIDE + ch * 8) = R.v[i]; }
        bf16x8 qf[2]; u32x2 ga[4];
        { const size_t tokq0 = (size_t)(tok0 + (wave >> 2) * 16 + r);
#pragma unroll
          for (int ks = 0; ks < 2; ++ks) qf[ks] = *(const bf16x8*)(HQ + tokq0 * NQ + hq * 64 + 32 * ks + 8 * Gq);
#pragma unroll
          for (int dt = 0; dt < 4; ++dt) ga[dt] = *(const u32x2*)(HQ + tokq0 * NQ + C_GA + hq * 64 + dt * 16 + 4 * Gq); }
        const float sink2 = sinks[hq] * L2E;
        __syncthreads(); asm volatile("" ::: "memory");
        if (item + G < NITEMS) attn_load_kv(R, HQ, item + G, tid);
#pragma unroll
        for (int pi = 0; pi < 4; ++pi) {
            const int qt = (wave >> 2) + 2 * pi, i0 = qt * 16;
            const size_t tokq = (size_t)(tok0 + i0 + r);
            bf16x8 qn[2]; u32x2 gn[4];
            if (pi < 3) { const size_t tokn = tokq + 32;
#pragma unroll
                for (int ks = 0; ks < 2; ++ks) qn[ks] = *(const bf16x8*)(HQ + tokn * NQ + hq * 64 + 32 * ks + 8 * Gq);
#pragma unroll
                for (int dt = 0; dt < 4; ++dt) gn[dt] = *(const u32x2*)(HQ + tokn * NQ + C_GA + hq * 64 + dt * 16 + 4 * Gq); }
            f32x4 S[9];
#pragma unroll
            for (int kt = 0; kt < 9; ++kt) { f32x4 a = (f32x4){0.f, 0.f, 0.f, 0.f};
#pragma unroll
                for (int ks = 0; ks < 2; ++ks) { const bf16x8 kf = *(const LAS bf16x8*)(Ks + (i0 + kt * 16 + r) * KS_STRIDE + 32 * ks + 8 * Gq);
                    a = __builtin_amdgcn_mfma_f32_16x16x32_bf16(kf, qf[ks], a, 0, 0, 0); }
                S[kt] = a; if (kt % 3 == 2) __builtin_amdgcn_sched_barrier(0); }
            asm volatile("" ::: "memory");
            float mx = -3.0e38f;
#pragma unroll
            for (int kt = 0; kt < 9; ++kt) { const bool dead = (nblk == 0) && (i0 + 16 * kt < 128);
#pragma unroll
                for (int i = 0; i < 4; ++i) { float t = S[kt][i] * SC;
                    if (kt == 0) t = (4 * Gq + i > r) ? t : -3.0e38f;
                    if (kt == 8) t = (4 * Gq + i <= r) ? t : -3.0e38f;
                    t = dead ? -3.0e38f : t; S[kt][i] = t; mx = fmaxf(mx, t); } }
            mx = fmaxf(mx, __shfl_xor(mx, 16)); mx = fmaxf(mx, __shfl_xor(mx, 32));
            const float mm = fmaxf(mx, sink2); float sum = 0.f;
#pragma unroll
            for (int kt = 0; kt < 9; ++kt)
#pragma unroll
                for (int i = 0; i < 4; ++i) { const float p = __builtin_amdgcn_exp2f(S[kt][i] - mm); S[kt][i] = p; sum += p; }
            sum += __shfl_xor(sum, 16); sum += __shfl_xor(sum, 32);
            const float inv = 1.0f / (sum + __builtin_amdgcn_exp2f(sink2 - mm));
            bf16x8 pf[5];
#pragma unroll
            for (int kk = 0; kk < 4; ++kk) { u32x4 w; w.x = pk2(S[2 * kk][0], S[2 * kk][1]); w.y = pk2(S[2 * kk][2], S[2 * kk][3]); w.z = pk2(S[2 * kk + 1][0], S[2 * kk + 1][1]); w.w = pk2(S[2 * kk + 1][2], S[2 * kk + 1][3]);
                pf[kk] = __builtin_bit_cast(bf16x8, w); }
            { u32x4 w; w.x = pk2(S[8][0], S[8][1]); w.y = pk2(S[8][2], S[8][3]); w.z = 0u; w.w = 0u; pf[4] = __builtin_bit_cast(bf16x8, w); }
            __builtin_amdgcn_sched_barrier(0);
            const unsigned vbase = lds_addr_of(Vs) + (unsigned)(((i0 + 4 * Gq + (r >> 2)) * VS_STRIDE + 4 * (r & 3)) * 2);
#pragma unroll
            for (int dt = 0; dt < 4; ++dt) {
                s16x4 lo[5], hi[4];
                unsigned vb = vbase + (unsigned)(dt * 32); asm volatile("" : "+v"(vb));
#pragma unroll
                for (int kk = 0; kk < 5; ++kk) { const unsigned a0 = vb + (unsigned)(32 * kk * VS_STRIDE * 2);
                    lo[kk] = tr_read_nw(a0); if (kk < 4) hi[kk] = tr_read_nw(a0 + 16 * VS_STRIDE * 2); }
                TR_WAIT_FIRST(lo[0]);
#pragma unroll
                for (int kk = 0; kk < 5; ++kk) { if (kk > 0) TR_DEP(lo[kk]); if (kk < 4) TR_DEP(hi[kk]); }
                f32x4 o = (f32x4){0.f, 0.f, 0.f, 0.f};
#pragma unroll
                for (int kk = 0; kk < 5; ++kk) { const s16x4 l4 = lo[kk]; s16x4 h4 = (s16x4){0, 0, 0, 0}; if (kk < 4) h4 = hi[kk];
                    const bf16x8 vf = (bf16x8){l4[0], l4[1], l4[2], l4[3], h4[0], h4[1], h4[2], h4[3]};
                    o = __builtin_amdgcn_mfma_f32_16x16x32_bf16(vf, pf[kk], o, 0, 0, 0); }
                const int col = hq * 64 + dt * 16 + 4 * Gq; const u32x2 gg = ga[dt];
                u32x2 w; w.x = pk2(o[0] * inv * bfl(gg.x), o[1] * inv * bfh(gg.x)); w.y = pk2(o[2] * inv * bfl(gg.y), o[3] * inv * bfh(gg.y));
                *(u32x2*)(Y + tokq * 512 + col) = w;
                asm volatile("" ::: "memory"); __builtin_amdgcn_sched_barrier(0); }
            if (pi < 3) {
#pragma unroll
                for (int ks = 0; ks < 2; ++ks) qf[ks] = qn[ks];
#pragma unroll
                for (int dt = 0; dt < 4; ++dt) ga[dt] = gn[dt]; }
        }
        asm volatile("" ::: "memory"); __syncthreads();
    }
}

constexpr int VN_STRIDE = 528;
struct SguBlk { f32x4 wa[4], wb[4]; };
__device__ __forceinline__ void sgu_load_blk(SguBlk& B, const float* __restrict__ w_s, int blk, int p, int r, int Gq) {
    const int g = blk >> 1, tt = (blk & 1) ? 7 - p : p, nks = (tt >> 1) + 1, t = tt * 16 + r;
    const float* wrow = w_s + ((size_t)g * 128 + t) * 128 + 4 * Gq;
#pragma unroll
    for (int ks = 0; ks < 4; ++ks) if (ks < nks) { B.wa[ks] = *(const f32x4*)(wrow + 32 * ks); B.wb[ks] = *(const f32x4*)(wrow + 32 * ks + 16); }
}
__device__ __forceinline__ void sgu_phase(LAS unsigned char* lds, const bf16* __restrict__ HQ, bf16* __restrict__ Y, const float* __restrict__ vn_g, const float* __restrict__ vn_b,
                                          const float* __restrict__ w_s, const float* __restrict__ b_s, int bx, int G, int wave, int lane) {
    constexpr int NITEMS = BATCH * 32;
    LAS bf16* Vn = (LAS bf16*)lds;
    const int r = lane & 15, Gq = lane >> 4, p = wave & 3, dh = wave >> 2;
    const unsigned nbase = lds_addr_of(Vn) + (unsigned)(((4 * Gq + (r >> 2)) * VN_STRIDE + 4 * (r & 3)) * 2);
    float gam[8], bet[8];
#pragma unroll
    for (int j = 0; j < 8; ++j) { gam[j] = vn_g[lane * 8 + j]; bet[j] = vn_b[lane * 8 + j]; }
    for (int bn = bx; bn < NITEMS; bn += G) {
        const size_t tok0 = (size_t)bn * 128;
        SguBlk cur; sgu_load_blk(cur, w_s, 0, p, r, Gq);
        u32x4 V[16];
#pragma unroll
        for (int i = 0; i < 16; ++i) V[i] = *(const u32x4*)(HQ + (tok0 + wave * 16 + i) * NQ + C_VB + lane * 8);
#pragma unroll
        for (int i = 0; i < 16; ++i) { const int s = wave * 16 + i; const u32x4 w = V[i];
            float v[8] = {bfl(w.x), bfh(w.x), bfl(w.y), bfh(w.y), bfl(w.z), bfh(w.z), bfl(w.w), bfh(w.w)};
            const float sm = ((v[0] + v[1]) + (v[2] + v[3])) + ((v[4] + v[5]) + (v[6] + v[7]));
            const float mean = wave_sum(sm) * (1.f / 512.f); float q = 0.f;
#pragma unroll
            for (int j = 0; j < 8; ++j) { v[j] -= mean; q += v[j] * v[j]; }
            const float rstd = 1.f / sqrtf(wave_sum(q) * (1.f / 512.f) + LN_EPS);
#pragma unroll
            for (int j = 0; j < 8; ++j) v[j] = v[j] * rstd * gam[j] + bet[j];
            u32x4 o; o.x = pk2(v[0], v[1]); o.y = pk2(v[2], v[3]); o.z = pk2(v[4], v[5]); o.w = pk2(v[6], v[7]);
            *(LAS u32x4*)(Vn + s * VN_STRIDE + lane * 8) = o; }
        __syncthreads(); asm volatile("" ::: "memory");
#pragma unroll
        for (int blk = 0; blk < 8; ++blk) {
            SguBlk nxt; if (blk < 7) sgu_load_blk(nxt, w_s, blk + 1, p, r, Gq);
            const int g = blk >> 1, tt = (blk & 1) ? 7 - p : p, nks = (tt >> 1) + 1, t = tt * 16 + r;
            const size_t tok = tok0 + t;
            u32x2 uu4[4], gb4[4]; const float bs = b_s[g * 128 + t];
            { const bf16* hrow = HQ + tok * NQ + g * 128 + dh * 64 + 4 * Gq;
#pragma unroll
              for (int di = 0; di < 4; ++di) { uu4[di] = *(const u32x2*)(hrow + C_U + di * 16); gb4[di] = *(const u32x2*)(hrow + C_GB + di * 16); } }
            bf16x8 wf[4];
#pragma unroll
            for (int ks = 0; ks < 4; ++ks) { if (ks < nks) { const int s0 = 32 * ks + 4 * Gq; f32x4 a = cur.wa[ks], b = cur.wb[ks];
                    if (ks == nks - 1) {
#pragma unroll
                        for (int j = 0; j < 4; ++j) { a[j] = (s0 + j <= t) ? a[j] : 0.f; b[j] = (s0 + 16 + j <= t) ? b[j] : 0.f; } }
                    u32x4 w; w.x = pk2(a[0], a[1]); w.y = pk2(a[2], a[3]); w.z = pk2(b[0], b[1]); w.w = pk2(b[2], b[3]);
                    wf[ks] = __builtin_bit_cast(bf16x8, w); } else wf[ks] = (bf16x8){0, 0, 0, 0, 0, 0, 0, 0}; }
#pragma unroll
            for (int dpair = 0; dpair < 2; ++dpair) {
                s16x4 lo[2][4], hi[2][4];
                unsigned nb = nbase + (unsigned)((g * 128 + (dh * 4 + 2 * dpair) * 16) * 2); asm volatile("" : "+v"(nb));
#pragma unroll
                for (int dd = 0; dd < 2; ++dd)
#pragma unroll
                    for (int ks = 0; ks < 4; ++ks) { const unsigned a0 = nb + (unsigned)((32 * ks * VN_STRIDE + dd * 16) * 2);
                        if (ks < nks) { lo[dd][ks] = tr_read_nw(a0); hi[dd][ks] = tr_read_nw(a0 + 16 * VN_STRIDE * 2); } else { lo[dd][ks] = (s16x4){0, 0, 0, 0}; hi[dd][ks] = (s16x4){0, 0, 0, 0}; } }
                TR_WAIT_FIRST(lo[0][0]);
#pragma unroll
                for (int dd = 0; dd < 2; ++dd)
#pragma unroll
                    for (int ks = 0; ks < 4; ++ks) { TR_DEP(lo[dd][ks]); TR_DEP(hi[dd][ks]); }
#pragma unroll
                for (int dd = 0; dd < 2; ++dd) { const int di = 2 * dpair + dd; f32x4 c = (f32x4){0.f, 0.f, 0.f, 0.f};
#pragma unroll
                    for (int ks = 0; ks < 4; ++ks) { if (ks < nks) { const s16x4 l4 = lo[dd][ks], h4 = hi[dd][ks];
                            const bf16x8 vf = (bf16x8){l4[0], l4[1], l4[2], l4[3], h4[0], h4[1], h4[2], h4[3]};
                            c = __builtin_amdgcn_mfma_f32_16x16x32_bf16(vf, wf[ks], c, 0, 0, 0); } }
                    const int col = g * 128 + (dh * 4 + di) * 16 + 4 * Gq; const u32x2 uu = uu4[di], gb = gb4[di];
                    u32x2 w; w.x = pk2(bfl(uu.x) * (c[0] + bs) * bfl(gb.x), bfh(uu.x) * (c[1] + bs) * bfh(gb.x)); w.y = pk2(bfl(uu.y) * (c[2] + bs) * bfl(gb.y), bfh(uu.y) * (c[3] + bs) * bfh(gb.y));
                    *(u32x2*)(Y + tok * 512 + col) = w; }
                asm volatile("" ::: "memory"); __builtin_amdgcn_sched_barrier(0);
            }
            if (blk < 7) cur = nxt;
        }
        asm volatile("" ::: "memory"); __syncthreads();
    }
}

struct Args { const float* in[16]; float* out; unsigned char* ws; };
typedef __attribute__((address_space(4))) const Args* KArgs;
#define PHASE_ENV() KArgs ka = (KArgs)__builtin_amdgcn_kernarg_segment_ptr(); asm volatile("" : "+s"(ka)); \
    int tid = threadIdx.x; asm volatile("" : "+v"(tid)); const int lane = tid & 63, wave = __builtin_amdgcn_readfirstlane(tid >> 6); \
    const int G = gridDim.x, bx = blockIdx.x; unsigned char* ws = ka->ws; (void)lane; (void)wave; (void)G; (void)bx; (void)ws

__device__ __forceinline__ void phase_prologue(LAS unsigned char* lds) {
    PHASE_ENV();
    const int gw = bx * NWAVES + wave, ngw = G * NWAVES;
    bf16* WT = (bf16*)(ws + WS_W);
    LAS float* scr = (LAS float*)(lds + wave * 16384);
    constexpr int I_IN = (D / 64) * (IN_COLS / 32), I_P = (512 / 64) * (D / 32), I_O = (D / 64) * (D / 32), I_L = I_IN + 2 * I_P + I_O;
    for (int it = gw; it < DEPTH * I_L; it += ngw) {
        const int l = it / I_L; int rr = it % I_L; bf16* wl = WT + (size_t)l * W_LAYER_E;
        if (rr < I_IN) { transpose_item(ka->in[3] + (size_t)l * D * IN_COLS, D, IN_COLS, wl, scr, rr, lane); continue; } rr -= I_IN;
        if (rr < I_P) { transpose_item(ka->in[10] + (size_t)l * 512 * D, 512, D, wl + W_IN_E, scr, rr, lane); continue; } rr -= I_P;
        if (rr < I_P) { transpose_item(ka->in[11] + (size_t)l * 512 * D, 512, D, wl + W_IN_E + W_P_E, scr, rr, lane); continue; } rr -= I_P;
        transpose_item(ka->in[12] + (size_t)l * D * D, D, D, wl + W_IN_E + 2 * W_P_E, scr, rr, lane);
    }
    ln_phase(ka->in[0], ka->out, (bf16*)(ws + WS_XB), ka->in[1], ka->in[2], gw, ngw, lane);
}
__device__ __forceinline__ void phase_inproj(LAS unsigned char* lds, int l) {
    PHASE_ENV();
    pg8::Gemm g{(const bf16*)(ws + WS_XB), (const bf16*)(ws + WS_W) + (size_t)l * W_LAYER_E, M, IN_COLS, D}; pg8::StaticOrder S; S.init(M, IN_COLS, G, bx);
    pg8::EpiIn E{(bf16*)(ws + WS_HQ), (bf16*)(ws + WS_HR), ka->in[4] + (size_t)l * IN_COLS};
    pg8::gemm_phase<pg8::EpiIn, pg8::StaticOrder, true, true>(lds, g, S, E);
}
__device__ __forceinline__ void phase_mixers(LAS unsigned char* lds, int l) {
    PHASE_ENV();
    const bf16* HQ = (const bf16*)(ws + WS_HQ); bf16* YA = (bf16*)(ws + WS_Y); bf16* YB = YA + (size_t)M * 512;
    attn_phase(lds, HQ, YA, ka->in[5] + l * 8, bx, G, tid, wave, lane);
    sgu_phase(lds, HQ, YB, ka->in[6] + l * 512, ka->in[7] + l * 512, ka->in[8] + (size_t)l * 4 * 128 * 128, ka->in[9] + l * 512, bx, G, wave, lane);
}
template <int MODE> __device__ __forceinline__ void phase_gate(LAS unsigned char* lds, int l) {
    PHASE_ENV();
    const bf16* YA = (const bf16*)(ws + WS_Y);
    pg8::Gemm g{YA + (size_t)MODE * M * 512, (const bf16*)(ws + WS_W) + (size_t)l * W_LAYER_E + W_IN_E + (size_t)MODE * W_P_E, M, D, 512}; pg8::StaticOrder S; S.init(M, D, G, bx);
    pg8::EpiGate<MODE> E{(const bf16*)(ws + WS_HR), (bf16*)(ws + WS_MG), MODE * 1024};
    pg8::gemm_phase<pg8::EpiGate<MODE>, pg8::StaticOrder, true, true>(lds, g, S, E);
}
__device__ __forceinline__ void phase_outproj(LAS unsigned char* lds, int l) {
    PHASE_ENV();
    pg8::Gemm g{(const bf16*)(ws + WS_MG), (const bf16*)(ws + WS_W) + (size_t)l * W_LAYER_E + W_IN_E + 2 * W_P_E, M, D, D}; pg8::StaticOrder S; S.init(M, D, G, bx);
    pg8::EpiOut E{ka->out, ka->in[13] + (size_t)l * D, ALPHA};
    pg8::gemm_phase<pg8::EpiOut, pg8::StaticOrder, true, true>(lds, g, S, E);
}
__device__ __forceinline__ void phase_ln(int l) {
    PHASE_ENV();
    const int gw = bx * NWAVES + wave, ngw = G * NWAVES;
    ln_phase(ka->out, ka->out, (l + 1 < DEPTH) ? (bf16*)(ws + WS_XB) : nullptr, ka->in[14] + (size_t)l * D, ka->in[15] + (size_t)l * D, gw, ngw, lane);
}


#ifdef SELFTEST
constexpr size_t WS_ST = WS_END;
__device__ __forceinline__ unsigned st_hash(unsigned x) { x ^= x >> 16; x *= 0x7feb352du; x ^= x >> 15; x *= 0x846ca68bu; x ^= x >> 16; return x; }
__device__ __forceinline__ float bf2f(bf16 b) { return __uint_as_float(((unsigned)b) << 16); }
__device__ __forceinline__ float rbf(float f) { return __uint_as_float(f2bf(f) << 16); }
__device__ __forceinline__ void st_acc(float* st, int k, float got, float ref) { const float e = got - ref; atomicAdd(st + 2 * k, (e == e) ? e * e : 1e30f); atomicAdd(st + 2 * k + 1, ref * ref); }
__device__ void phase_selftest(int l) {
    PHASE_ENV();
    float* st = (float*)(ws + WS_ST);
    const bf16* XB = (const bf16*)(ws + WS_XB); const bf16* HQ = (const bf16*)(ws + WS_HQ); const bf16* HR = (const bf16*)(ws + WS_HR);
    const bf16* YA = (const bf16*)(ws + WS_Y); const bf16* YB = YA + (size_t)M * 512; const bf16* MG = (const bf16*)(ws + WS_MG);
    const unsigned gt = (unsigned)(bx * NTHREADS + tid);
    const unsigned h1 = st_hash(gt * 2654435761u + 12345u), h2 = st_hash(h1 + 0x9e3779b9u);
    { const int t = (int)(h1 % (unsigned)M), c = (int)(h2 % (unsigned)IN_COLS);
      const float* w = ka->in[3] + (size_t)l * D * IN_COLS; float a = 0.f;
      for (int k = 0; k < D; ++k) a += bf2f(XB[(size_t)t * D + k]) * rbf(w[(size_t)k * IN_COLS + c]);
      a += ka->in[4][l * IN_COLS + c];
      const int seg = c < 768 ? 0 : (c < 1280 ? 1 : (c < 2304 ? 2 : (c < 2816 ? 1 : 3)));
      float ref = a;
      if (seg == 1) ref = a / (1.f + expf(-a));
      if (seg == 2) ref = 0.5f * a * (1.f + tanhf(0.7978845608f * (a + 0.044715f * a * a * a)));
      if (seg == 3) ref = 1.f / (1.f + expf(-a));
      const float got = c < NQ ? bf2f(HQ[(size_t)t * NQ + c]) : bf2f(HR[(size_t)t * NR + (c - NQ)]);
      st_acc(st, 2, got, ref); }
    { const int t = (int)(h2 % (unsigned)M), c = (int)(h1 % 1024u);
      const float* pa = ka->in[10] + (size_t)l * 512 * D; const float* pb = ka->in[11] + (size_t)l * 512 * D; float a = 0.f, b = 0.f;
      for (int k = 0; k < 512; ++k) { a += bf2f(YA[(size_t)t * 512 + k]) * rbf(pa[(size_t)k * D + c]); b += bf2f(YB[(size_t)t * 512 + k]) * rbf(pb[(size_t)k * D + c]); }
      const float ref = bf2f(HR[(size_t)t * NR + c]) * a + bf2f(HR[(size_t)t * NR + 1024 + c]) * b;
      st_acc(st, 3, bf2f(MG[(size_t)t * D + c]), ref); }
    { const unsigned h3 = st_hash(h2 + 77u); int t = (int)(h3 % (unsigned)M); const int col = (int)(h1 % 512u), hq = col >> 6, d = col & 63, kvh = hq >> 2;
      if ((gt & 7u) == 0u) t = (t & ~4095) | (t & 127);
      const int s = t & 4095, jlo = s - 127 > 0 ? s - 127 : 0; const size_t tb = (size_t)(t - s);
      const float sink = ka->in[5][l * 8 + hq];
      float mx = sink;
      for (int j = jlo; j <= s; ++j) { float sc = 0.f; for (int k = 0; k < 64; ++k) sc += bf2f(HQ[(size_t)t * NQ + hq * 64 + k]) * bf2f(HQ[(tb + j) * NQ + C_K + kvh * 64 + k]); sc *= 0.125f; mx = fmaxf(mx, sc); }
      float den = expf(sink - mx), o = 0.f;
      for (int j = jlo; j <= s; ++j) { float sc = 0.f; for (int k = 0; k < 64; ++k) sc += bf2f(HQ[(size_t)t * NQ + hq * 64 + k]) * bf2f(HQ[(tb + j) * NQ + C_K + kvh * 64 + k]); sc *= 0.125f;
          const float p = expf(sc - mx); den += p; o += p * bf2f(HQ[(tb + j) * NQ + C_V + kvh * 64 + d]); }
      const float ref = o / den * bf2f(HQ[(size_t)t * NQ + C_GA + col]);
      st_acc(st, 0, bf2f(YA[(size_t)t * 512 + col]), ref); }
    if ((tid & 15) == 0) { const unsigned h3 = st_hash(h1 + 991u); const int t = (int)(h3 % (unsigned)M), c = (int)(h2 % 512u), g = c >> 7, tt = t & 127; const size_t t0 = (size_t)(t - tt);
      const float* w_s = ka->in[8] + (size_t)l * 4 * 128 * 128; float mixed = ka->in[9][l * 512 + g * 128 + tt];
      for (int sidx = 0; sidx <= tt; ++sidx) { const bf16* vr = HQ + (t0 + sidx) * NQ + C_VB; float mu = 0.f; for (int k = 0; k < 512; ++k) mu += bf2f(vr[k]); mu *= (1.f / 512.f);
          float var = 0.f; for (int k = 0; k < 512; ++k) { const float dv = bf2f(vr[k]) - mu; var += dv * dv; } var *= (1.f / 512.f);
          const float vn = (bf2f(vr[c]) - mu) / sqrtf(var + LN_EPS) * ka->in[6][l * 512 + c] + ka->in[7][l * 512 + c];
          mixed += w_s[((size_t)g * 128 + tt) * 128 + sidx] * vn; }
      const float ref = bf2f(HQ[(size_t)t * NQ + C_U + c]) * mixed * bf2f(HQ[(size_t)t * NQ + C_GB + c]);
      st_acc(st, 1, bf2f(YB[(size_t)t * 512 + c]), ref); }
}

__device__ void st_copy(const float* src, float* dst) { PHASE_ENV(); const f32x4* s4 = (const f32x4*)src; f32x4* d4 = (f32x4*)dst;
    for (size_t i = (size_t)bx * NTHREADS + tid; i < (size_t)M * D / 4; i += (size_t)G * NTHREADS) d4[i] = s4[i]; }
__device__ void phase_selftest_out(int l) {
    PHASE_ENV();
    float* st = (float*)(ws + WS_ST); const float* XC = (const float*)(ws + WS_HQ); const bf16* MG = (const bf16*)(ws + WS_MG);
    const unsigned gt = (unsigned)(bx * NTHREADS + tid); const unsigned h1 = st_hash(gt * 2654435761u + 4242u), h2 = st_hash(h1 + 0x9e3779b9u);
    const int t = (int)(h1 % (unsigned)M), c = (int)(h2 % 1024u);
    const float* w = ka->in[12] + (size_t)l * D * D; float a = 0.f;
    for (int k = 0; k < D; ++k) a += bf2f(MG[(size_t)t * D + k]) * rbf(w[(size_t)k * D + c]);
    a += ka->in[13][l * D + c];
    const float got = ka->out[(size_t)t * D + c] - ALPHA * XC[(size_t)t * D + c];
    st_acc(st, 0, got, a);
}
__device__ void phase_selftest_ln(int l) {
    PHASE_ENV();
    float* st = (float*)(ws + WS_ST); const float* ZC = (const float*)(ws + WS_HR);
    const unsigned gt = (unsigned)(bx * NTHREADS + tid); const unsigned h1 = st_hash(gt * 2654435761u + 777u), h2 = st_hash(h1 + 0x9e3779b9u);
    if ((tid & 7) == 0) { const int t = (int)(h1 % (unsigned)M), c = (int)(h2 % 1024u); const float* zr = ZC + (size_t)t * D;
        float mu = 0.f; for (int k = 0; k < D; ++k) mu += zr[k]; mu *= (1.f / D);
        float var = 0.f; for (int k = 0; k < D; ++k) { const float dv = zr[k] - mu; var += dv * dv; } var *= (1.f / D);
        const float ref = (zr[c] - mu) / sqrtf(var + LN_EPS) * ka->in[14][l * D + c] + ka->in[15][l * D + c];
        const float got = ka->out[(size_t)t * D + c];
        st_acc(st, 1, ref + (got - ref) * 100.f, ref); }
}

__device__ void phase_selftest_seg(int l) {
    PHASE_ENV();
    float* st = (float*)(ws + WS_ST);
    const bf16* XB = (const bf16*)(ws + WS_XB); const bf16* HQ = (const bf16*)(ws + WS_HQ); const bf16* HR = (const bf16*)(ws + WS_HR);
    const unsigned gt = (unsigned)(bx * NTHREADS + tid); const unsigned h1 = st_hash(gt * 2654435761u + 999u), h2 = st_hash(h1 + 0x9e3779b9u);
    const int t = (int)(h1 % (unsigned)M), k4 = (int)(gt & 3u);
    const int c = (k4 == 0 ? 1280 : (k4 == 1 ? 1792 : (k4 == 2 ? 2304 : 3840))) + (int)(h2 % 512u);
    const float* w = ka->in[3] + (size_t)l * D * IN_COLS; float a = 0.f;
    for (int k = 0; k < D; ++k) a += bf2f(XB[(size_t)t * D + k]) * rbf(w[(size_t)k * IN_COLS + c]);
    a += ka->in[4][l * IN_COLS + c];
    float ref = a;
    if (k4 == 2) ref = a / (1.f + expf(-a));
    if (k4 < 2) ref = 0.5f * a * (1.f + tanhf(0.7978845608f * (a + 0.044715f * a * a * a)));
    if (k4 == 3) ref = 1.f / (1.f + expf(-a));
    const float got = c < NQ ? bf2f(HQ[(size_t)t * NQ + c]) : bf2f(HR[(size_t)t * NR + (c - NQ)]);
    st_acc(st, k4, ref + (got - ref) * 3.f, ref);
}
__device__ __forceinline__ int st_class(float sse, float ssr) { if (!(sse == sse) || sse > 1e29f) return 6; const float r = sqrtf(sse / (ssr + 1e-30f)); return r < 0.005f ? 0 : (r < 0.015f ? 1 : (r < 0.05f ? 2 : (r < 0.15f ? 3 : (r < 0.5f ? 4 : 5)))); }
__device__ void phase_selftest_report() {
    PHASE_ENV();
    const float* st = (const float*)(ws + WS_ST);
    const int c0 = st_class(st[0], st[1]), c1 = st_class(st[2], st[3]), c2 = st_class(st[4], st[5]), c3 = st_class(st[6], st[7]);
#ifndef ST_THRESH
#define ST_THRESH 2
#endif
    if (c0 >= ST_THRESH || c1 >= ST_THRESH || c2 >= ST_THRESH || c3 >= ST_THRESH) {
        const float V = 1.0e4f * (float)(10 * (c0 + 1) + c1);
        const int N = 100 * (10 * (c2 + 1) + c3);
        for (int i = bx * NTHREADS + tid; i < N; i += G * NTHREADS) ka->out[(size_t)i * 4099] = V;
    }
}
#endif

__device__ __forceinline__ void grid_bar(LAS unsigned char* lds) {
    KArgs ka = (KArgs)__builtin_amdgcn_kernarg_segment_ptr(); asm volatile("" : "+s"(ka));
    XcdBarrier b; b.bar = (unsigned*)(ka->ws + WS_CTL); b.x = xb_xcc_id(); b.st = (volatile LAS unsigned*)(lds + XBAR_LDS_OFF);
    xcd_barrier(b);
}
#ifdef STAMPS
#define STAMP(k) do { if (blockIdx.x == 0 && threadIdx.x == 0) ((unsigned long long*)(args.ws + WS_END + 1024))[k] = __builtin_amdgcn_s_memrealtime(); } while (0)
#else
#define STAMP(k) do { } while (0)
#endif
__global__ void __launch_bounds__(NTHREADS, 2) fwd_megakernel(Args args) {
    extern __shared__ __attribute__((aligned(16))) unsigned char lds_raw[];
    LAS unsigned char* lds = (LAS unsigned char*)lds_raw;
    cg::grid_group grid = cg::this_grid();
    if (threadIdx.x < 16) ((LAS unsigned*)(lds + XBAR_LDS_OFF))[threadIdx.x] = 0u;
    __syncthreads();
    (void)xcd_barrier_post((unsigned*)(args.ws + WS_CTL), (volatile LAS unsigned*)(lds + XBAR_LDS_OFF));
#define GRID_BAR() grid_bar(lds)
#ifdef SELFTEST
    if (blockIdx.x == 0 && threadIdx.x < 16) ((float*)(args.ws + WS_ST))[threadIdx.x] = 0.f;
#endif
    STAMP(0);
    phase_prologue(lds); __syncthreads();
    grid.sync(); STAMP(1);
#pragma unroll
    for (int l = 0; l < DEPTH; ++l) {
        phase_inproj(lds, l);        GRID_BAR();  STAMP(2 + 5 * l);
        phase_mixers(lds, l);        GRID_BAR();  STAMP(3 + 5 * l);
        phase_gate<0>(lds, l);
        phase_gate<1>(lds, l);       GRID_BAR();  STAMP(4 + 5 * l);
#ifdef SELFTEST
#if ST_PART == 3
        if (l == ST_LAYER) { phase_selftest_seg(l); grid.sync(); }
#elif ST_PART == 1
        if (l == ST_LAYER) { phase_selftest(l); grid.sync(); }
#else
        if (l == ST_LAYER) { st_copy(((KArgs)__builtin_amdgcn_kernarg_segment_ptr())->out, (float*)(((KArgs)__builtin_amdgcn_kernarg_segment_ptr())->ws + WS_HQ)); grid.sync(); }
#endif
#endif
        phase_outproj(lds, l);       GRID_BAR();  STAMP(5 + 5 * l);
#if defined(SELFTEST) && ST_PART == 2
        if (l == ST_LAYER) { phase_selftest_out(l); st_copy(((KArgs)__builtin_amdgcn_kernarg_segment_ptr())->out, (float*)(((KArgs)__builtin_amdgcn_kernarg_segment_ptr())->ws + WS_HR)); grid.sync(); }
#endif
        phase_ln(l);
#if defined(SELFTEST) && ST_PART == 2
        if (l == ST_LAYER) { grid.sync(); phase_selftest_ln(l); }
#endif
        if (l + 1 < DEPTH) GRID_BAR();
        STAMP(6 + 5 * l);
    }
#ifdef STAMPS
    grid.sync();
    { const unsigned long long* T = (const unsigned long long*)(args.ws + WS_END + 1024);
      const float da = (float)(T[STAMP_A + 1] - T[STAMP_A]) * 0.01f, db = (float)(T[STAMP_B + 1] - T[STAMP_B]) * 0.01f;
      const float V = da * 100.f; const int N = (int)db;
      for (int i = blockIdx.x * NTHREADS + threadIdx.x; i < N; i += gridDim.x * NTHREADS) args.out[(size_t)i * 4099] = V; }
#endif
#ifdef SELFTEST
    grid.sync(); phase_selftest_report();
#endif
}

extern "C" void kernel_launch(void* const* d_in, const int* in_sizes, int n_in, void* d_out, int out_size, void* d_ws, size_t ws_size, hipStream_t stream) {
    static int grid = 0;
    if (grid == 0) {
        if (n_in != 16 || in_sizes[0] != M * D || out_size != M * D || ws_size < WS_CTL + CTL_BYTES) { fprintf(stderr, "kernel_launch: unexpected shapes (n_in %d, in0 %d, out %d, ws %zu)\n", n_in, n_in > 0 ? in_sizes[0] : -1, out_size, ws_size); grid = -1; return; }
        int dev = 0, cus = 0, per_cu = 0;
        hipGetDevice(&dev); hipDeviceGetAttribute(&cus, hipDeviceAttributeMultiprocessorCount, dev);
        if (hipFuncSetAttribute((const void*)fwd_megakernel, hipFuncAttributeMaxDynamicSharedMemorySize, LDS_BYTES) != hipSuccess) { fprintf(stderr, "kernel_launch: hipFuncSetAttribute failed\n"); grid = -1; return; }
        if (hipOccupancyMaxActiveBlocksPerMultiprocessor(&per_cu, (const void*)fwd_megakernel, NTHREADS, LDS_BYTES) != hipSuccess || per_cu < 1) { fprintf(stderr, "kernel_launch: occupancy query says %d\n", per_cu); per_cu = 1; }
        (void)hipGetLastError();
        grid = cus * 1;
        if (grid <= 0) grid = 256;
    }
    if (grid < 0) return;
    if (hipMemsetAsync((char*)d_ws + WS_CTL, 0, CTL_BYTES, stream) != hipSuccess) { fprintf(stderr, "kernel_launch: memset of the barrier words failed\n"); return; }
    Args a{};
    for (int i = 0; i < 16; ++i) a.in[i] = (const float*)d_in[i];
    a.out = (float*)d_out; a.ws = (unsigned char*)d_ws;
    void* kargs[] = {&a};
    hipError_t e = hipLaunchCooperativeKernel((const void*)fwd_megakernel, dim3(grid), dim3(NTHREADS), kargs, LDS_BYTES, stream);
    if (e != hipSuccess) fprintf(stderr, "kernel_launch: cooperative launch failed: %s (grid %d)\n", hipGetErrorString(e), grid);
}
```

```cpp
#include <hip/hip_runtime.h>
#include <hip/hip_cooperative_groups.h>
#include <cstdio>
#include <cstdint>
namespace pg8 {
#define PG8_LAS __attribute__((address_space(3)))
typedef unsigned short bf16_t;
typedef short bf16x8 __attribute__((ext_vector_type(8)));
typedef float f32x4 __attribute__((ext_vector_type(4)));
typedef unsigned u32x4 __attribute__((ext_vector_type(4)));
constexpr int BM = 256, BK = 64, HALF = 128, HTB = HALF * BK * 2  , STAGE_BYTES = 8 * HTB, NXCD = 8, WGM = 8;

__host__ __device__ __forceinline__ int lds_byte(int r, int c) { const int st = (r >> 4) * 2 + (c >> 5), rr = r & 15, cc = c & 31, ob = rr * 64 + cc * 2; return st * 1024 + (ob ^ (((ob >> 9) & 1) << 5)); }
__host__ __device__ __forceinline__ void stage_rc(int b, int& R, int& C) { const int st = b / 1024, sb = b % 1024, swz = sb ^ (((sb >> 9) & 1) << 5); R = (st >> 1) * 16 + swz / 64; C = (st & 1) * 32 + (swz % 64) / 2; }
__host__ __device__ __forceinline__ int perm32(int rho) { const int n = rho >> 4, i = rho & 15; return 8 * (i >> 2) + 4 * n + (i & 3); }

struct Unit { int pm, pn; };
struct Gemm { const bf16_t* A; const bf16_t* Bt; int M, N, K; };

struct StaticOrder {
    int nM, nN, nwg, G, c;
    __host__ __device__ void init(int M, int N, int G_, int c_) { nM = M / BM; nN = N / BM; nwg = nM * nN; G = G_; c = c_; }
    __host__ __device__ bool next(int i, Unit& u) const {
        const long L = (long)i * G + c; if (L >= nwg) return false;
        int wgid = (int)L; { const int q = nwg / NXCD, r = nwg % NXCD, xcd = wgid % NXCD, off = wgid / NXCD; wgid = (xcd < r ? xcd * (q + 1) : r * (q + 1) + (xcd - r) * q) + off; }
        const int nig = WGM * nN, gid = wgid / nig, fm = gid * WGM, gsz = (nM - fm) < WGM ? (nM - fm) : WGM;
        u.pm = fm + ((wgid % nig) % gsz); u.pn = (wgid % nig) / gsz; return true;
    }
    __device__ __forceinline__ void a_ready(const Unit&) const {}
    __device__ __forceinline__ void done(const Unit&) const {}
};

__device__ __forceinline__ unsigned cvt_pk_bf16(float lo, float hi) { unsigned r; asm volatile("v_cvt_pk_bf16_f32 %0, %1, %2" : "=v"(r) : "v"(lo), "v"(hi)); return r; }
typedef float f32x2 __attribute__((ext_vector_type(2)));
__device__ __forceinline__ float bf_lo(unsigned w) { return __uint_as_float(w << 16); }
__device__ __forceinline__ float bf_hi(unsigned w) { return __uint_as_float(w & 0xffff0000u); }
struct EpiIn {
    static constexpr bool PERM = true, AFTER_DRAIN = false;
    bf16_t* HQ; bf16_t* HR; const float* bias;
    __device__ __forceinline__ void operator()(const f32x4 (&acc)[2][2][4][2], const Unit& u, int wr, int wc, int fr, int fq) const {
        const int row0 = u.pm * BM + wr * 64 + fr, pn = u.pn;
        bf16_t* base; int ldc, colt;
        if (pn < 11) { base = HQ; ldc = 2816; colt = pn * 256; } else { base = HR; ldc = 2048; colt = (pn - 11) * 256; }
        const int act = pn < 3 ? 0 : (pn < 5 ? 1 : (pn < 9 ? 2 : (pn < 11 ? 1 : 3)));
        const float a1 = (act == 2) ? -2.302208198f : -1.442695041f;
        const float a3 = (act == 2) ? -0.1029432397f : 0.f;
        const int col0 = colt + wc * 32 + 8 * fq, bcol0 = pn * BM + wc * 32 + 8 * fq;
        f32x4 bv[2][2];
#pragma unroll
        for (int bj = 0; bj < 2; ++bj)
#pragma unroll
            for (int n = 0; n < 2; ++n) bv[bj][n] = *(const f32x4*)(bias + bcol0 + bj * HALF + 4 * n);
#pragma unroll
        for (int ai = 0; ai < 2; ++ai)
#pragma unroll
            for (int m = 0; m < 4; ++m) { bf16_t* rowp = base + (size_t)(row0 + ai * HALF + m * 16) * ldc + col0;
#pragma unroll
                for (int bj = 0; bj < 2; ++bj) { f32x4 v0 = acc[ai][bj][m][0] + bv[bj][0], v1 = acc[ai][bj][m][1] + bv[bj][1];
                    if (act != 0) {
#pragma unroll
                        for (int j = 0; j < 4; ++j) {
                            const float x0 = v0[j], x1 = v1[j];
                            const float s0 = __builtin_amdgcn_rcpf(1.0f + __builtin_amdgcn_exp2f(x0 * (a1 + a3 * x0 * x0)));
                            const float s1 = __builtin_amdgcn_rcpf(1.0f + __builtin_amdgcn_exp2f(x1 * (a1 + a3 * x1 * x1)));
                            v0[j] = (act == 3) ? s0 : x0 * s0; v1[j] = (act == 3) ? s1 : x1 * s1; } }
                    u32x4 w; w.x = cvt_pk_bf16(v0[0], v0[1]); w.y = cvt_pk_bf16(v0[2], v0[3]); w.z = cvt_pk_bf16(v1[0], v1[1]); w.w = cvt_pk_bf16(v1[2], v1[3]);
                    *(u32x4*)(rowp + bj * HALF) = w; } }
    }
};
template <int MODE> struct EpiGate {
    static constexpr bool PERM = true, AFTER_DRAIN = false;
    const bf16_t* HR; bf16_t* MG; int goff;
    __device__ __forceinline__ void operator()(const f32x4 (&acc)[2][2][4][2], const Unit& u, int wr, int wc, int fr, int fq) const {
        const int row0 = u.pm * BM + wr * 64 + fr, col0 = u.pn * BM + wc * 32 + 8 * fq;
        constexpr int MB = 4;
#pragma unroll
        for (int ab = 0; ab < 8 / MB; ++ab) { const int ai = (ab * MB) >> 2, m0 = (ab * MB) & 3;
            u32x4 gw[4][2], pw[4][2];
#pragma unroll
            for (int m = m0; m < m0 + MB; ++m) { const size_t row = (size_t)(row0 + ai * HALF + m * 16);
#pragma unroll
                for (int bj = 0; bj < 2; ++bj) { gw[m][bj] = *(const u32x4*)(HR + row * 2048 + goff + col0 + bj * HALF);
                    if (MODE == 1) pw[m][bj] = *(const u32x4*)(MG + row * 1024 + col0 + bj * HALF); } }
#pragma unroll
            for (int m = m0; m < m0 + MB; ++m) { const size_t row = (size_t)(row0 + ai * HALF + m * 16);
#pragma unroll
                for (int bj = 0; bj < 2; ++bj) { const u32x4 g4 = gw[m][bj];
                    f32x4 v0 = acc[ai][bj][m][0], v1 = acc[ai][bj][m][1];
                    v0[0] *= bf_lo(g4.x); v0[1] *= bf_hi(g4.x); v0[2] *= bf_lo(g4.y); v0[3] *= bf_hi(g4.y);
                    v1[0] *= bf_lo(g4.z); v1[1] *= bf_hi(g4.z); v1[2] *= bf_lo(g4.w); v1[3] *= bf_hi(g4.w);
                    if (MODE == 1) { const u32x4 p4 = pw[m][bj];
                        v0[0] += bf_lo(p4.x); v0[1] += bf_hi(p4.x); v0[2] += bf_lo(p4.y); v0[3] += bf_hi(p4.y);
                        v1[0] += bf_lo(p4.z); v1[1] += bf_hi(p4.z); v1[2] += bf_lo(p4.w); v1[3] += bf_hi(p4.w); }
                    u32x4 w; w.x = cvt_pk_bf16(v0[0], v0[1]); w.y = cvt_pk_bf16(v0[2], v0[3]); w.z = cvt_pk_bf16(v1[0], v1[1]); w.w = cvt_pk_bf16(v1[2], v1[3]);
                    *(u32x4*)(MG + row * 1024 + col0 + bj * HALF) = w; } }
            asm volatile("" ::: "memory"); }
    }
};
struct EpiOut {
    static constexpr bool PERM = false, AFTER_DRAIN = false;
    float* X; const float* bias; float alpha;
    __device__ __forceinline__ void operator()(const f32x4 (&acc)[2][2][4][2], const Unit& u, int wr, int wc, int fr, int fq) const {
        const int row0 = u.pm * BM + wr * 64 + fr, col0 = u.pn * BM + wc * 32 + 4 * fq;
        f32x4 bv[2][2];
#pragma unroll
        for (int bj = 0; bj < 2; ++bj)
#pragma unroll
            for (int n = 0; n < 2; ++n) bv[bj][n] = *(const f32x4*)(bias + col0 + bj * HALF + n * 16);
        constexpr int MB = 2;
#pragma unroll
        for (int ab = 0; ab < 8 / MB; ++ab) { const int ai = (ab * MB) >> 2, m0 = (ab * MB) & 3;
            f32x4 xr[4][2][2];
#pragma unroll
            for (int m = m0; m < m0 + MB; ++m) { const float* rowp = X + (size_t)(row0 + ai * HALF + m * 16) * 1024 + col0;
#pragma unroll
                for (int bj = 0; bj < 2; ++bj)
#pragma unroll
                    for (int n = 0; n < 2; ++n) xr[m][bj][n] = *(const f32x4*)(rowp + bj * HALF + n * 16); }
#pragma unroll
            for (int m = m0; m < m0 + MB; ++m) { float* rowp = X + (size_t)(row0 + ai * HALF + m * 16) * 1024 + col0;
#pragma unroll
                for (int bj = 0; bj < 2; ++bj)
#pragma unroll
                    for (int n = 0; n < 2; ++n) *(f32x4*)(rowp + bj * HALF + n * 16) = xr[m][bj][n] * alpha + (acc[ai][bj][m][n] + bv[bj][n]); }
            asm volatile("" ::: "memory"); }
    }
};

template <class Epi, class Sched, bool ALIGN_EPI = false, bool SP2 = false>
__device__ __forceinline__ void gemm_phase(PG8_LAS unsigned char* lds, const Gemm g, const Sched& S, const Epi& E) {
    int tid_ = threadIdx.x; asm volatile("" : "+v"(tid_));
    const int tid = tid_, wid = __builtin_amdgcn_readfirstlane(tid >> 6), lane = tid & 63, wr = wid >> 2, wc = wid & 3, fr = lane & 15, fq = lane >> 4;
    const int K = g.K, nt = K / BK;
    unsigned voffA[2], voffB[2];
#pragma unroll
    for (int i = 0; i < 2; ++i) { int R, C; stage_rc(tid * 16 + i * 8192, R, C); const int Rb = Epi::PERM ? ((R & ~31) + perm32(R & 31)) : R;
        voffA[i] = (unsigned)(R * K + C) * 2u; voffB[i] = (unsigned)(Rb * K + C) * 2u; }
    const size_t kstep = (size_t)(BK * 2);
    const size_t hstep = (size_t)HALF * K * 2;
    const size_t tstep = 2 * hstep;
    const unsigned ldsw = (unsigned)wid * 1024u;
    const int aoff = lds_byte(wr * 64 + fr, fq * 8), boff = lds_byte(wc * 32 + fr, fq * 8);
#define PG8_SA(b, h) (((b) * 2 + (h)) * HTB)
#define PG8_SB(b, h) ((4 + (b) * 2 + (h)) * HTB)
#define PG8_STAGE(bufoff, gbase, voff) do { _Pragma("unroll") for (int _i = 0; _i < 2; ++_i) \
        __builtin_amdgcn_global_load_lds((const unsigned*)((const char*)(gbase) + (voff)[_i]), (PG8_LAS unsigned*)(lds + (bufoff) + ldsw + _i * 8192), 16, 0, 0); } while (0)
#define PG8_LDA(dst, b, h) do { _Pragma("unroll") for (int m = 0; m < 4; ++m) _Pragma("unroll") for (int k = 0; k < 2; ++k) dst[m][k] = *(const PG8_LAS bf16x8*)(lds + PG8_SA(b, h) + aoff + m * 2048 + k * 1024); } while (0)
#define PG8_LDB(dst, b, h) do { _Pragma("unroll") for (int n = 0; n < 2; ++n) _Pragma("unroll") for (int k = 0; k < 2; ++k) dst[n][k] = *(const PG8_LAS bf16x8*)(lds + PG8_SB(b, h) + boff + n * 2048 + k * 1024); } while (0)
#define PG8_MMA(ai, bj, At, Bt) do { __builtin_amdgcn_s_setprio(1); _Pragma("unroll") for (int m = 0; m < 4; ++m) _Pragma("unroll") for (int n = 0; n < 2; ++n) _Pragma("unroll") for (int k = 0; k < 2; ++k) \
        acc[ai][bj][m][n] = __builtin_amdgcn_mfma_f32_16x16x32_bf16(Bt[n][k], At[m][k], acc[ai][bj][m][n], 0, 0, 0); __builtin_amdgcn_s_setprio(0); } while (0)
#define PG8_WAIT_V(n) asm volatile("s_waitcnt vmcnt(" #n ")" ::: "memory")
#define PG8_WAIT_L(n) asm volatile("s_waitcnt lgkmcnt(" #n ")" ::: "memory")
#define PG8_BAR __builtin_amdgcn_s_barrier()
#define PG8_SCHED __builtin_amdgcn_sched_barrier(0)
    Unit cur, nxt; int ui = 0;
    if (!S.next(0, cur)) return;
    f32x4 acc[2][2][4][2];
#pragma unroll
    for (int a = 0; a < 2; ++a)
#pragma unroll
        for (int b = 0; b < 2; ++b)
#pragma unroll
            for (int m = 0; m < 4; ++m)
#pragma unroll
                for (int n = 0; n < 2; ++n) acc[a][b][m][n] = (f32x4){0.f, 0.f, 0.f, 0.f};
    bf16x8 At[4][2], B0[2][2], B1[2][2];
    const char* cA = (const char*)g.A + (size_t)cur.pm * tstep; const char* cB = (const char*)g.Bt + (size_t)cur.pn * tstep;
    S.a_ready(cur);
    if constexpr (SP2) {
        PG8_STAGE(PG8_SB(0, 0), cB, voffB); PG8_STAGE(PG8_SB(0, 1), cB + hstep, voffB); PG8_STAGE(PG8_SA(0, 0), cA, voffA); PG8_STAGE(PG8_SA(0, 1), cA + hstep, voffA);
        if (wr == 1) PG8_BAR;
        PG8_WAIT_V(2); PG8_BAR;
        PG8_STAGE(PG8_SB(1, 0), cB + kstep, voffB); PG8_STAGE(PG8_SA(1, 0), cA + kstep, voffA); PG8_STAGE(PG8_SB(1, 1), cB + hstep + kstep, voffB);
        PG8_WAIT_V(6); PG8_BAR;
    } else {
        PG8_STAGE(PG8_SB(0, 0), cB, voffB); PG8_STAGE(PG8_SA(0, 0), cA, voffA); PG8_STAGE(PG8_SB(0, 1), cB + hstep, voffB); PG8_STAGE(PG8_SA(0, 1), cA + hstep, voffA);
        if (wr == 1) PG8_BAR;
        PG8_WAIT_V(4); PG8_BAR;
        PG8_STAGE(PG8_SB(1, 0), cB + kstep, voffB); PG8_STAGE(PG8_SA(1, 0), cA + kstep, voffA); PG8_STAGE(PG8_SB(1, 1), cB + hstep + kstep, voffB);
        PG8_WAIT_V(6); PG8_BAR;
    }
    for (;;) {
        const bool has_next = S.next(ui + 1, nxt);
        const char* nA = has_next ? (const char*)g.A + (size_t)nxt.pm * tstep : cA; const char* nB = has_next ? (const char*)g.Bt + (size_t)nxt.pn * tstep : cB;
        for (int t = 0; t < nt; t += 2) {
            const bool last = (t == nt - 2);
            const char* a1 = cA + (size_t)(t + 1) * kstep;
            const char* a2 = last ? nA : cA + (size_t)(t + 2) * kstep; const char* b2 = last ? nB : cB + (size_t)(t + 2) * kstep;
            const char* a3 = a2 + kstep; const char* b3 = b2 + kstep;
            if (last && has_next) S.a_ready(nxt);
            if constexpr (SP2) {
            PG8_LDB(B0, 0, 0); PG8_LDB(B1, 0, 1); PG8_SCHED; PG8_LDA(At, 0, 0); PG8_STAGE(PG8_SA(1, 1), a1 + hstep, voffA);
            PG8_WAIT_V(8); PG8_WAIT_L(0); PG8_BAR; PG8_MMA(0, 0, At, B0); PG8_MMA(0, 1, At, B1); PG8_BAR; PG8_SCHED;
            PG8_LDA(At, 0, 1); PG8_STAGE(PG8_SB(0, 0), b2, voffB); PG8_STAGE(PG8_SB(0, 1), b2 + hstep, voffB); PG8_STAGE(PG8_SA(0, 0), a2, voffA);
            PG8_WAIT_V(8); PG8_WAIT_L(0); PG8_BAR; PG8_MMA(1, 0, At, B0); PG8_MMA(1, 1, At, B1); PG8_BAR; PG8_SCHED;
            PG8_LDB(B0, 1, 0); PG8_LDB(B1, 1, 1); PG8_SCHED; PG8_LDA(At, 1, 0); PG8_STAGE(PG8_SA(0, 1), a2 + hstep, voffA);
            PG8_WAIT_V(8); PG8_WAIT_L(0); PG8_BAR; PG8_MMA(0, 0, At, B0); PG8_MMA(0, 1, At, B1); PG8_BAR; PG8_SCHED;
            PG8_LDA(At, 1, 1); PG8_STAGE(PG8_SB(1, 0), b3, voffB); PG8_STAGE(PG8_SB(1, 1), b3 + hstep, voffB); PG8_STAGE(PG8_SA(1, 0), a3, voffA);
            PG8_WAIT_V(8); PG8_WAIT_L(0); PG8_BAR; PG8_MMA(1, 0, At, B0); PG8_MMA(1, 1, At, B1); PG8_BAR; PG8_SCHED;
            } else {
            PG8_LDB(B0, 0, 0); PG8_SCHED; PG8_LDA(At, 0, 0); PG8_STAGE(PG8_SA(1, 1), a1 + hstep, voffA);
            PG8_WAIT_L(8); PG8_BAR; PG8_WAIT_L(0); PG8_MMA(0, 0, At, B0); PG8_BAR; PG8_SCHED;
            PG8_LDB(B1, 0, 1); PG8_STAGE(PG8_SB(0, 0), b2, voffB);
            PG8_BAR; PG8_WAIT_L(0); PG8_MMA(0, 1, At, B1); PG8_BAR;
            PG8_LDA(At, 0, 1); PG8_STAGE(PG8_SA(0, 0), a2, voffA);
            PG8_BAR; PG8_WAIT_L(0); PG8_MMA(1, 0, At, B0); PG8_BAR; PG8_SCHED;
            PG8_STAGE(PG8_SB(0, 1), b2 + hstep, voffB);
            PG8_WAIT_V(6); PG8_BAR; PG8_MMA(1, 1, At, B1); PG8_BAR;
            PG8_LDB(B0, 1, 0); PG8_SCHED; PG8_LDA(At, 1, 0); PG8_STAGE(PG8_SA(0, 1), a2 + hstep, voffA);
            PG8_WAIT_L(8); PG8_BAR; PG8_WAIT_L(0); PG8_MMA(0, 0, At, B0); PG8_BAR; PG8_SCHED;
            PG8_LDB(B1, 1, 1); PG8_STAGE(PG8_SB(1, 0), b3, voffB);
            PG8_BAR; PG8_WAIT_L(0); PG8_MMA(0, 1, At, B1); PG8_BAR;
            PG8_LDA(At, 1, 1); PG8_STAGE(PG8_SA(1, 0), a3, voffA);
            PG8_BAR; PG8_WAIT_L(0); PG8_MMA(1, 0, At, B0); PG8_BAR; PG8_SCHED;
            PG8_STAGE(PG8_SB(1, 1), b3 + hstep, voffB);
            PG8_WAIT_V(6); PG8_BAR; PG8_MMA(1, 1, At, B1); PG8_BAR;
            }
        }
        if constexpr (ALIGN_EPI) { if (wr == 0) PG8_BAR; }
        if constexpr (!Epi::AFTER_DRAIN) { E(acc, cur, wr, wc, fr, fq); S.done(cur); }
        if (!has_next) break;
#pragma unroll
        for (int a = 0; a < 2; ++a)
#pragma unroll
            for (int b = 0; b < 2; ++b)
#pragma unroll
                for (int m = 0; m < 4; ++m)
#pragma unroll
                    for (int n = 0; n < 2; ++n) acc[a][b][m][n] = (f32x4){0.f, 0.f, 0.f, 0.f};
        cur = nxt; cA = nA; cB = nB; ++ui;
        if constexpr (ALIGN_EPI) { if (wr == 1) PG8_BAR; }
    }
    PG8_WAIT_V(0);
    if constexpr (!ALIGN_EPI) { if (wr == 0) PG8_BAR; }
    PG8_BAR;
    if constexpr (Epi::AFTER_DRAIN) { E.fused(acc, cur, wr, wc, fr, fq, lds, wid, lane); S.done(cur); }
#undef PG8_SA
#undef PG8_SB
#undef PG8_STAGE
#undef PG8_LDA
#undef PG8_LDB
#undef PG8_MMA
#undef PG8_WAIT_V
#undef PG8_WAIT_L
#undef PG8_BAR
#undef PG8_SCHED
}
}

namespace cg = cooperative_groups;
#define LAS __attribute__((address_space(3)))
typedef unsigned short bf16;
typedef short bf16x8 __attribute__((ext_vector_type(8)));
typedef short s16x4 __attribute__((ext_vector_type(4)));
typedef float f32x4 __attribute__((ext_vector_type(4)));
typedef unsigned u32x4 __attribute__((ext_vector_type(4)));
typedef unsigned u32x2 __attribute__((ext_vector_type(2)));

constexpr int D = 1024, BATCH = 16, SEQ = 4096, DEPTH = 2, M = BATCH * SEQ;
constexpr int IN_COLS = 4864, NQ = 2816, NR = 2048;
constexpr int C_K = 512, C_V = 640, C_GA = 768, C_U = 1280, C_VB = 1792, C_GB = 2304;
constexpr float LN_EPS = 1e-5f, ALPHA = 1.41421356237f;
constexpr int NWAVES = 8, NTHREADS = 512;
constexpr int LDS_BYTES = 143360;
constexpr size_t MiB = 1u << 20;
constexpr size_t WS_W = 0;
constexpr size_t W_IN_E = (size_t)IN_COLS * D, W_P_E = (size_t)D * 512, W_O_E = (size_t)D * D, W_LAYER_E = W_IN_E + 2 * W_P_E + W_O_E;
constexpr size_t WS_XB = 28 * MiB;
constexpr size_t WS_HQ = WS_XB + 128 * MiB;
constexpr size_t WS_HR = WS_HQ + 352 * MiB;
constexpr size_t WS_Y  = WS_HR + 256 * MiB;
constexpr size_t WS_MG = WS_Y + 128 * MiB;
constexpr size_t WS_END = WS_MG + 128 * MiB;
constexpr size_t WS_CTL = WS_END + 65536, CTL_BYTES = 16384;
constexpr int XBAR_LDS_OFF = LDS_BYTES - 64;
static_assert(2 * W_LAYER_E * 2 <= WS_XB, "weights fit");

__device__ __forceinline__ unsigned f2bf(float f) { unsigned u = __builtin_bit_cast(unsigned, f); return (u + 0x7fffu + ((u >> 16) & 1u)) >> 16; }
__device__ __forceinline__ unsigned pk2(float lo, float hi) { return f2bf(lo) | (f2bf(hi) << 16); }
__device__ __forceinline__ float bfl(unsigned w) { return __uint_as_float(w << 16); }
__device__ __forceinline__ float bfh(unsigned w) { return __uint_as_float(w & 0xffff0000u); }
__device__ __forceinline__ float wave_sum(float v) {
#pragma unroll
    for (int o = 1; o < 64; o <<= 1) v += __shfl_xor(v, o);
    return v;
}
__device__ __forceinline__ s16x4 tr_read(unsigned lds_addr) { s16x4 r; asm volatile("ds_read_b64_tr_b16 %0, %1\n\ts_waitcnt lgkmcnt(0)" : "=&v"(r) : "v"(lds_addr) : "memory"); return r; }
__device__ __forceinline__ unsigned lds_addr_of(const LAS void* p) { return (unsigned)(uintptr_t)p; }

#define XB_TMO      128
#define XB_XCNT(j)  (256  + 64 * (j))
#define XB_XSUB(j)  (1280 + 64 * (j))
#define XB_XGEN(j)  (2304 + 64 * (j))
#define XB_TOP      3328
#define XB_TOPGEN   3392
#define XCD_BAR_WORDS 3456
#define XB_SPIN_CAP (1u << 18)

__device__ __forceinline__ unsigned xb_ld(unsigned* p)              { return __hip_atomic_load(p, __ATOMIC_RELAXED, __HIP_MEMORY_SCOPE_AGENT); }
__device__ __forceinline__ unsigned xb_add(unsigned* p, unsigned v) { return __hip_atomic_fetch_add(p, v, __ATOMIC_RELAXED, __HIP_MEMORY_SCOPE_AGENT); }
__device__ __forceinline__ unsigned xb_xcc_id() { return (unsigned)__builtin_amdgcn_s_getreg((3 << 11) | 20) & 0xFu; }
#define XB_SPIN(cond, bar) do { unsigned _sp = 0; while (cond) { __builtin_amdgcn_s_sleep(1); \
    if ((++_sp & 255u) == 0u) { if (xb_ld(&(bar)[XB_TMO])) break; if (_sp > XB_SPIN_CAP) { atomicAdd(&(bar)[XB_TMO], 1u); break; } } } } while (0)

struct XcdBarrier {
    unsigned* bar; unsigned x;
    volatile LAS unsigned* st;
};

__device__ __forceinline__ XcdBarrier xcd_barrier_post(unsigned* bar, volatile LAS unsigned* st) {
    XcdBarrier b; b.bar = bar; b.x = xb_xcc_id(); b.st = st;
    if (threadIdx.x == 0) (void)xb_add(&bar[XB_XCNT(b.x)], 1u);
    return b;
}
__device__ __forceinline__ void xcd_barrier_complete(unsigned* bar, unsigned x, unsigned& nloc, unsigned& nx) {
    const unsigned G = gridDim.x * gridDim.y * gridDim.z;
    unsigned sum, cnt, mine, sp = 0u;
    for (;;) {
        sum = 0u; cnt = 0u; mine = 0u;
#pragma unroll
        for (unsigned j = 0; j < 16; ++j) { const unsigned c = xb_ld(&bar[XB_XCNT(j)]); sum += c; cnt += (c > 0u) ? 1u : 0u; mine = (j == x) ? c : mine; }
        if (sum == G) break;
        __builtin_amdgcn_s_sleep(1);
        if ((++sp & 255u) == 0u) { if (xb_ld(&bar[XB_TMO])) break; if (sp > XB_SPIN_CAP) { atomicAdd(&bar[XB_TMO], 1u); break; } }
    }
    nloc = mine > 0u ? mine : 1u; nx = cnt > 0u ? cnt : 1u;
}

__device__ __forceinline__ void xcd_barrier(const XcdBarrier& b) {
    asm volatile("s_waitcnt vmcnt(0)" ::: "memory");
    __syncthreads();
    if (threadIdx.x == 0) {
        unsigned* bar = b.bar;
        __builtin_amdgcn_s_waitcnt(0);
        unsigned nloc = b.st[0], nx = b.st[1];
        if (nloc == 0u) { xcd_barrier_complete(bar, b.x, nloc, nx); b.st[0] = nloc; b.st[1] = nx; }
        const unsigned old = xb_add(&bar[XB_XSUB(b.x)], 1u);
        const unsigned gen = old / nloc;
        if (old + 1u == (gen + 1u) * nloc) {
            __builtin_amdgcn_fence(__ATOMIC_RELEASE, "agent");
            asm volatile("s_waitcnt vmcnt(0)" ::: "memory");
            const unsigned og = xb_add(&bar[XB_TOP], 1u);
            const unsigned tg = og / nx;
            if (og + 1u == (tg + 1u) * nx) xb_add(&bar[XB_TOPGEN], 1u);
            else XB_SPIN(xb_ld(&bar[XB_TOPGEN]) == tg, bar);
            __builtin_amdgcn_fence(__ATOMIC_ACQUIRE, "agent");
            xb_add(&bar[XB_XGEN(b.x)], 1u);
            asm volatile("s_waitcnt vmcnt(0)" ::: "memory");
        } else {
            XB_SPIN(xb_ld(&bar[XB_XGEN(b.x)]) == gen, bar);
            __builtin_amdgcn_fence(__ATOMIC_ACQUIRE, "agent");
            asm volatile("s_waitcnt vmcnt(0)" ::: "memory");
        }
    }
    __syncthreads();
}

__device__ __forceinline__ void transpose_item(const float* W, int K, int N, bf16* WT, LAS float* scr, int item, int lane) {
    const int nblk = N / 32, kb = item / nblk, nb = item % nblk, k0 = 64 * kb, n0 = 32 * nb;
#pragma unroll 8
    for (int i = 0; i < 32; ++i) { const int kk = 2 * i + (lane >> 5); scr[kk * 33 + (lane & 31)] = W[(size_t)(k0 + kk) * N + n0 + (lane & 31)]; }
    asm volatile("s_waitcnt lgkmcnt(0)" ::: "memory");
    const int c = lane & 7;
#pragma unroll
    for (int j = 0; j < 4; ++j) { const int n = (lane >> 3) + 8 * j; const LAS float* s = scr + (8 * c) * 33 + n;
        u32x4 o; o.x = pk2(s[0 * 33], s[1 * 33]); o.y = pk2(s[2 * 33], s[3 * 33]); o.z = pk2(s[4 * 33], s[5 * 33]); o.w = pk2(s[6 * 33], s[7 * 33]);
        *(u32x4*)(WT + (size_t)(n0 + n) * K + k0 + 8 * c) = o; }
    asm volatile("s_waitcnt lgkmcnt(0)" ::: "memory");
}
__device__ __forceinline__ void ln_row(const float* xrow, float* orow, bf16* ob, const f32x4 (&gv)[4], const f32x4 (&bv)[4], int lane) {
    const f32x4* xr = (const f32x4*)xrow + lane;
    f32x4 v[4]; float s = 0.f;
#pragma unroll
    for (int j = 0; j < 4; ++j) { v[j] = xr[64 * j]; s += (v[j].x + v[j].y) + (v[j].z + v[j].w); }
    const float mean = wave_sum(s) * (1.f / D); float s2 = 0.f;
#pragma unroll
    for (int j = 0; j < 4; ++j) { v[j] = v[j] - mean; s2 += (v[j].x * v[j].x + v[j].y * v[j].y) + (v[j].z * v[j].z + v[j].w * v[j].w); }
    const float rstd = 1.f / sqrtf(wave_sum(s2) * (1.f / D) + LN_EPS);
    f32x4* o4 = (f32x4*)orow + lane;
#pragma unroll
    for (int j = 0; j < 4; ++j) { v[j] = v[j] * rstd * gv[j] + bv[j]; o4[64 * j] = v[j]; }
    if (ob) { unsigned long long* o8 = (unsigned long long*)ob + lane;
#pragma unroll
        for (int j = 0; j < 4; ++j) o8[64 * j] = (unsigned long long)pk2(v[j].x, v[j].y) | ((unsigned long long)pk2(v[j].z, v[j].w) << 32); }
}
__device__ __forceinline__ void ln_phase(const float* src, float* dst, bf16* xb, const float* g, const float* b, int gw, int ngw, int lane) {
    f32x4 gv[4], bv[4];
#pragma unroll
    for (int j = 0; j < 4; ++j) { gv[j] = ((const f32x4*)g)[lane + 64 * j]; bv[j] = ((const f32x4*)b)[lane + 64 * j]; }
    for (int m = gw; m < M; m += ngw) ln_row(src + (size_t)m * D, dst + (size_t)m * D, xb ? xb + (size_t)m * D : nullptr, gv, bv, lane);
}

constexpr int KS_STRIDE = 72, VS_STRIDE = 80, KS_BYTES = 256 * KS_STRIDE * 2;
__device__ __forceinline__ s16x4 tr_read_nw(unsigned lds_addr) { s16x4 r; asm volatile("ds_read_b64_tr_b16 %0, %1" : "=&v"(r) : "v"(lds_addr)); return r; }
#define TR_WAIT_FIRST(x) asm volatile("s_waitcnt lgkmcnt(0)" : "+v"(x))
#define TR_DEP(x) asm volatile("" : "+v"(x))
struct KVRegs { u32x4 k[4], v[4]; };
__device__ __forceinline__ void attn_load_kv(KVRegs& R, const bf16* __restrict__ HQ, int item, int tid) {
    const int kvh = item & 1, bn = item >> 1, nblk = bn & 31; const long tok0 = (long)bn * 128;
#pragma unroll
    for (int i = 0; i < 4; ++i) { const int idx = tid + 512 * i, row = idx >> 3, ch = idx & 7;
        const long tr = ((nblk > 0) || (row >= 128)) ? (tok0 - 128 + row) : tok0;
        const bf16* src = HQ + (size_t)tr * NQ + C_K + kvh * 64 + ch * 8;
        R.k[i] = *(const u32x4*)src; R.v[i] = *(const u32x4*)(src + 128); }
}
__device__ __forceinline__ void attn_phase(LAS unsigned char* lds, const bf16* __restrict__ HQ, bf16* __restrict__ Y, const float* __restrict__ sinks, int bx, int G, int tid, int wave, int lane) {
    constexpr int NITEMS = BATCH * 32 * 2;
    LAS bf16* Ks = (LAS bf16*)lds; LAS bf16* Vs = (LAS bf16*)(lds + KS_BYTES);
    const int r = lane & 15, Gq = lane >> 4, g = wave & 3;
    const float L2E = 1.4426950409f, SC = 0.125f * L2E;
    KVRegs R;
    int item = bx;
    if (item < NITEMS) attn_load_kv(R, HQ, item, tid);
    for (; item < NITEMS; item += G) {
        const int kvh = item & 1, bn = item >> 1, nblk = bn & 31, hq = kvh * 4 + g; const long tok0 = (long)bn * 128;
#pragma unroll
        for (int i = 0; i < 4; ++i) { const int idx = tid + 512 * i, row = idx >> 3, ch = idx & 7;
            *(LAS u32x4*)(Ks + row * KS_STRIDE + ch * 8) = R.k[i]; *(LAS u32x4*)(Vs + row * VS_STRIDE + ch * 8) = R.v[i]; }
        bf16x8 qf[2]; u32x2 ga[4];
        { const size_t tokq0 = (size_t)(tok0 + (wave >> 2) * 16 + r);
#pragma unroll
          for (int ks = 0; ks < 2; ++ks) qf[ks] = *(const bf16x8*)(HQ + tokq0 * NQ + hq * 64 + 32 * ks + 8 * Gq);
#pragma unroll
          for (int dt = 0; dt < 4; ++dt) ga[dt] = *(const u32x2*)(HQ + tokq0 * NQ + C_GA + hq * 64 + dt * 16 + 4 * Gq); }
        const float sink2 = sinks[hq] * L2E;
        __syncthreads(); asm volatile("" ::: "memory");
        if (item + G < NITEMS) attn_load_kv(R, HQ, item + G, tid);
#pragma unroll
        for (int pi = 0; pi < 4; ++pi) {
            const int qt = (wave >> 2) + 2 * pi, i0 = qt * 16;
            const size_t tokq = (size_t)(tok0 + i0 + r);
            bf16x8 qn[2]; u32x2 gn[4];
            if (pi < 3) { const size_t tokn = tokq + 32;
#pragma unroll
                for (int ks = 0; ks < 2; ++ks) qn[ks] = *(const bf16x8*)(HQ + tokn * NQ + hq * 64 + 32 * ks + 8 * Gq);
#pragma unroll
                for (int dt = 0; dt < 4; ++dt) gn[dt] = *(const u32x2*)(HQ + tokn * NQ + C_GA + hq * 64 + dt * 16 + 4 * Gq); }
            f32x4 S[9];
#pragma unroll
            for (int kt = 0; kt < 9; ++kt) { f32x4 a = (f32x4){0.f, 0.f, 0.f, 0.f};
#pragma unroll
                for (int ks = 0; ks < 2; ++ks) { const bf16x8 kf = *(const LAS bf16x8*)(Ks + (i0 + kt * 16 + r) * KS_STRIDE + 32 * ks + 8 * Gq);
                    a = __builtin_amdgcn_mfma_f32_16x16x32_bf16(kf, qf[ks], a, 0, 0, 0); }
                S[kt] = a; if (kt % 3 == 2) __builtin_amdgcn_sched_barrier(0); }
            asm volatile("" ::: "memory");
            float mx = -3.0e38f;
#pragma unroll
            for (int kt = 0; kt < 9; ++kt) { const bool dead = (nblk == 0) && (i0 + 16 * kt < 128);
#pragma unroll
                for (int i = 0; i < 4; ++i) { float t = S[kt][i] * SC;
                    if (kt == 0) t = (4 * Gq + i > r) ? t : -3.0e38f;
                    if (kt == 8) t = (4 * Gq + i <= r) ? t : -3.0e38f;
                    t = dead ? -3.0e38f : t; S[kt][i] = t; mx = fmaxf(mx, t); } }
            mx = fmaxf(mx, __shfl_xor(mx, 16)); mx = fmaxf(mx, __shfl_xor(mx, 32));
            const float mm = fmaxf(mx, sink2); float sum = 0.f;
#pragma unroll
            for (int kt = 0; kt < 9; ++kt)
#pragma unroll
                for (int i = 0; i < 4; ++i) { const float p = __builtin_amdgcn_exp2f(S[kt][i] - mm); S[kt][i] = p; sum += p; }
            sum += __shfl_xor(sum, 16); sum += __shfl_xor(sum, 32);
            const float inv = 1.0f / (sum + __builtin_amdgcn_exp2f(sink2 - mm));
            bf16x8 pf[5];
#pragma unroll
            for (int kk = 0; kk < 4; ++kk) { u32x4 w; w.x = pk2(S[2 * kk][0], S[2 * kk][1]); w.y = pk2(S[2 * kk][2], S[2 * kk][3]); w.z = pk2(S[2 * kk + 1][0], S[2 * kk + 1][1]); w.w = pk2(S[2 * kk + 1][2], S[2 * kk + 1][3]);
                pf[kk] = __builtin_bit_cast(bf16x8, w); }
            { u32x4 w; w.x = pk2(S[8][0], S[8][1]); w.y = pk2(S[8][2], S[8][3]); w.z = 0u; w.w = 0u; pf[4] = __builtin_bit_cast(bf16x8, w); }
            __builtin_amdgcn_sched_barrier(0);
            const unsigned vbase = lds_addr_of(Vs) + (unsigned)(((i0 + 4 * Gq + (r >> 2)) * VS_STRIDE + 4 * (r & 3)) * 2);
#pragma unroll
            for (int dt = 0; dt < 4; ++dt) {
                s16x4 lo[5], hi[4];
                unsigned vb = vbase + (unsigned)(dt * 32); asm volatile("" : "+v"(vb));
#pragma unroll
                for (int kk = 0; kk < 5; ++kk) { const unsigned a0 = vb + (unsigned)(32 * kk * VS_STRIDE * 2);
                    lo[kk] = tr_read_nw(a0); if (kk < 4) hi[kk] = tr_read_nw(a0 + 16 * VS_STRIDE * 2); }
                TR_WAIT_FIRST(lo[0]);
#pragma unroll
                for (int kk = 0; kk < 5; ++kk) { if (kk > 0) TR_DEP(lo[kk]); if (kk < 4) TR_DEP(hi[kk]); }
                f32x4 o = (f32x4){0.f, 0.f, 0.f, 0.f};
#pragma unroll
                for (int kk = 0; kk < 5; ++kk) { const s16x4 l4 = lo[kk]; s16x4 h4 = (s16x4){0, 0, 0, 0}; if (kk < 4) h4 = hi[kk];
                    const bf16x8 vf = (bf16x8){l4[0], l4[1], l4[2], l4[3], h4[0], h4[1], h4[2], h4[3]};
                    o = __builtin_amdgcn_mfma_f32_16x16x32_bf16(vf, pf[kk], o, 0, 0, 0); }
                const int col = hq * 64 + dt * 16 + 4 * Gq; const u32x2 gg = ga[dt];
                u32x2 w; w.x = pk2(o[0] * inv * bfl(gg.x), o[1] * inv * bfh(gg.x)); w.y = pk2(o[2] * inv * bfl(gg.y), o[3] * inv * bfh(gg.y));
                *(u32x2*)(Y + tokq * 512 + col) = w;
                asm volatile("" ::: "memory"); __builtin_amdgcn_sched_barrier(0); }
            if (pi < 3) {
#pragma unroll
                for (int ks = 0; ks < 2; ++ks) qf[ks] = qn[ks];
#pragma unroll
                for (int dt = 0; dt < 4; ++dt) ga[dt] = gn[dt]; }
        }
        asm volatile("" ::: "memory"); __syncthreads();
    }
}

constexpr int VN_STRIDE = 528;
struct SguBlk { f32x4 wa[4], wb[4]; };
__device__ __forceinline__ void sgu_load_blk(SguBlk& B, const float* __restrict__ w_s, int blk, int p, int r, int Gq) {
    const int g = blk >> 1, tt = (blk & 1) ? 7 - p : p, nks = (tt >> 1) + 1, t = tt * 16 + r;
    const float* wrow = w_s + ((size_t)g * 128 + t) * 128 + 4 * Gq;
#pragma unroll
    for (int ks = 0; ks < 4; ++ks) if (ks < nks) { B.wa[ks] = *(const f32x4*)(wrow + 32 * ks); B.wb[ks] = *(const f32x4*)(wrow + 32 * ks + 16); }
}
__device__ __forceinline__ void sgu_phase(LAS unsigned char* lds, const bf16* __restrict__ HQ, bf16* __restrict__ Y, const float* __restrict__ vn_g, const float* __restrict__ vn_b,
                                          const float* __restrict__ w_s, const float* __restrict__ b_s, int bx, int G, int wave, int lane) {
    constexpr int NITEMS = BATCH * 32;
    LAS bf16* Vn = (LAS bf16*)lds;
    const int r = lane & 15, Gq = lane >> 4, p = wave & 3, dh = wave >> 2;
    const unsigned nbase = lds_addr_of(Vn) + (unsigned)(((4 * Gq + (r >> 2)) * VN_STRIDE + 4 * (r & 3)) * 2);
    float gam[8], bet[8];
#pragma unroll
    for (int j = 0; j < 8; ++j) { gam[j] = vn_g[lane * 8 + j]; bet[j] = vn_b[lane * 8 + j]; }
    for (int bn = bx; bn < NITEMS; bn += G) {
        const size_t tok0 = (size_t)bn * 128;
        SguBlk cur; sgu_load_blk(cur, w_s, 0, p, r, Gq);
        u32x4 V[16];
#pragma unroll
        for (int i = 0; i < 16; ++i) V[i] = *(const u32x4*)(HQ + (tok0 + wave * 16 + i) * NQ + C_VB + lane * 8);
#pragma unroll
        for (int i = 0; i < 16; ++i) { const int s = wave * 16 + i; const u32x4 w = V[i];
            float v[8] = {bfl(w.x), bfh(w.x), bfl(w.y), bfh(w.y), bfl(w.z), bfh(w.z), bfl(w.w), bfh(w.w)};
            const float sm = ((v[0] + v[1]) + (v[2] + v[3])) + ((v[4] + v[5]) + (v[6] + v[7]));
            const float mean = wave_sum(sm) * (1.f / 512.f); float q = 0.f;
#pragma unroll
            for (int j = 0; j < 8; ++j) { v[j] -= mean; q += v[j] * v[j]; }
            const float rstd = 1.f / sqrtf(wave_sum(q) * (1.f / 512.f) + LN_EPS);
#pragma unroll
            for (int j = 0; j < 8; ++j) v[j] = v[j] * rstd * gam[j] + bet[j];
            u32x4 o; o.x = pk2(v[0], v[1]); o.y = pk2(v[2], v[3]); o.z = pk2(v[4], v[5]); o.w = pk2(v[6], v[7]);
            *(LAS u32x4*)(Vn + s * VN_STRIDE + lane * 8) = o; }
        __syncthreads(); asm volatile("" ::: "memory");
#pragma unroll
        for (int blk = 0; blk < 8; ++blk) {
            SguBlk nxt; if (blk < 7) sgu_load_blk(nxt, w_s, blk + 1, p, r, Gq);
            const int g = blk >> 1, tt = (blk & 1) ? 7 - p : p, nks = (tt >> 1) + 1, t = tt * 16 + r;
            const size_t tok = tok0 + t;
            u32x2 uu4[4], gb4[4]; const float bs = b_s[g * 128 + t];
            { const bf16* hrow = HQ + tok * NQ + g * 128 + dh * 64 + 4 * Gq;
#pragma unroll
              for (int di = 0; di < 4; ++di) { uu4[di] = *(const u32x2*)(hrow + C_U + di * 16); gb4[di] = *(const u32x2*)(hrow + C_GB + di * 16); } }
            bf16x8 wf[4];
#pragma unroll
            for (int ks = 0; ks < 4; ++ks) { if (ks < nks) { const int s0 = 32 * ks + 4 * Gq; f32x4 a = cur.wa[ks], b = cur.wb[ks];
                    if (ks == nks - 1) {
#pragma unroll
                        for (int j = 0; j < 4; ++j) { a[j] = (s0 + j <= t) ? a[j] : 0.f; b[j] = (s0 + 16 + j <= t) ? b[j] : 0.f; } }
                    u32x4 w; w.x = pk2(a[0], a[1]); w.y = pk2(a[2], a[3]); w.z = pk2(b[0], b[1]); w.w = pk2(b[2], b[3]);
                    wf[ks] = __builtin_bit_cast(bf16x8, w); } else wf[ks] = (bf16x8){0, 0, 0, 0, 0, 0, 0, 0}; }
#pragma unroll
            for (int dpair = 0; dpair < 2; ++dpair) {
                s16x4 lo[2][4], hi[2][4];
                unsigned nb = nbase + (unsigned)((g * 128 + (dh * 4 + 2 * dpair) * 16) * 2); asm volatile("" : "+v"(nb));
#pragma unroll
                for (int dd = 0; dd < 2; ++dd)
#pragma unroll
                    for (int ks = 0; ks < 4; ++ks) { const unsigned a0 = nb + (unsigned)((32 * ks * VN_STRIDE + dd * 16) * 2);
                        if (ks < nks) { lo[dd][ks] = tr_read_nw(a0); hi[dd][ks] = tr_read_nw(a0 + 16 * VN_STRIDE * 2); } else { lo[dd][ks] = (s16x4){0, 0, 0, 0}; hi[dd][ks] = (s16x4){0, 0, 0, 0}; } }
                TR_WAIT_FIRST(lo[0][0]);
#pragma unroll
                for (int dd = 0; dd < 2; ++dd)
#pragma unroll
                    for (int ks = 0; ks < 4; ++ks) { TR_DEP(lo[dd][ks]); TR_DEP(hi[dd][ks]); }
#pragma unroll
                for (int dd = 0; dd < 2; ++dd) { const int di = 2 * dpair + dd; f32x4 c = (f32x4){0.f, 0.f, 0.f, 0.f};
#pragma unroll
                    for (int ks = 0; ks < 4; ++ks) { if (ks < nks) { const s16x4 l4 = lo[dd][ks], h4 = hi[dd][ks];
                            const bf16x8 vf = (bf16x8){l4[0], l4[1], l4[2], l4[3], h4[0], h4[1], h4[2], h4[3]};
                            c = __builtin_amdgcn_mfma_f32_16x16x32_bf16(vf, wf[ks], c, 0, 0, 0); } }
                    const int col = g * 128 + (dh * 4 + di) * 16 + 4 * Gq; const u32x2 uu = uu4[di], gb = gb4[di];
                    u32x2 w; w.x = pk2(bfl(uu.x) * (c[0] + bs) * bfl(gb.x), bfh(uu.x) * (c[1] + bs) * bfh(gb.x)); w.y = pk2(bfl(uu.y) * (c[2] + bs) * bfl(gb.y), bfh(uu.y) * (c[3] + bs) * bfh(gb.y));
                    *(u32x2*)(Y + tok * 512 + col) = w; }
                asm volatile("" ::: "memory"); __builtin_amdgcn_sched_barrier(0);
            }
            if (blk < 7) cur = nxt;
        }
        asm volatile("" ::: "memory"); __syncthreads();
    }
}

struct Args { const float* in[16]; float* out; unsigned char* ws; };
typedef __attribute__((address_space(4))) const Args* KArgs;
#define PHASE_ENV() KArgs ka = (KArgs)__builtin_amdgcn_kernarg_segment_ptr(); asm volatile("" : "+s"(ka)); \
    int tid = threadIdx.x; asm volatile("" : "+v"(tid)); const int lane = tid & 63, wave = __builtin_amdgcn_readfirstlane(tid >> 6); \
    const int G = gridDim.x, bx = blockIdx.x; unsigned char* ws = ka->ws; (void)lane; (void)wave; (void)G; (void)bx; (void)ws

__device__ __forceinline__ void phase_prologue(LAS unsigned char* lds) {
    PHASE_ENV();
    const int gw = bx * NWAVES + wave, ngw = G * NWAVES;
    bf16* WT = (bf16*)(ws + WS_W);
    LAS float* scr = (LAS float*)(lds + wave * 16384);
    constexpr int I_IN = (D / 64) * (IN_COLS / 32), I_P = (512 / 64) * (D / 32), I_O = (D / 64) * (D / 32), I_L = I_IN + 2 * I_P + I_O;
    for (int it = gw; it < DEPTH * I_L; it += ngw) {
        const int l = it / I_L; int rr = it % I_L; bf16* wl = WT + (size_t)l * W_LAYER_E;
        if (rr < I_IN) { transpose_item(ka->in[3] + (size_t)l * D * IN_COLS, D, IN_COLS, wl, scr, rr, lane); continue; } rr -= I_IN;
        if (rr < I_P) { transpose_item(ka->in[10] + (size_t)l * 512 * D, 512, D, wl + W_IN_E, scr, rr, lane); continue; } rr -= I_P;
        if (rr < I_P) { transpose_item(ka->in[11] + (size_t)l * 512 * D, 512, D, wl + W_IN_E + W_P_E, scr, rr, lane); continue; } rr -= I_P;
        transpose_item(ka->in[12] + (size_t)l * D * D, D, D, wl + W_IN_E + 2 * W_P_E, scr, rr, lane);
    }
    ln_phase(ka->in[0], ka->out, (bf16*)(ws + WS_XB), ka->in[1], ka->in[2], gw, ngw, lane);
}
__device__ __forceinline__ void phase_inproj(LAS unsigned char* lds, int l) {
    PHASE_ENV();
    pg8::Gemm g{(const bf16*)(ws + WS_XB), (const bf16*)(ws + WS_W) + (size_t)l * W_LAYER_E, M, IN_COLS, D}; pg8::StaticOrder S; S.init(M, IN_COLS, G, bx);
    pg8::EpiIn E{(bf16*)(ws + WS_HQ), (bf16*)(ws + WS_HR), ka->in[4] + (size_t)l * IN_COLS};
    pg8::gemm_phase<pg8::EpiIn, pg8::StaticOrder, true, true>(lds, g, S, E);
}
__device__ __forceinline__ void phase_mixers(LAS unsigned char* lds, int l) {
    PHASE_ENV();
    const bf16* HQ = (const bf16*)(ws + WS_HQ); bf16* YA = (bf16*)(ws + WS_Y); bf16* YB = YA + (size_t)M * 512;
    attn_phase(lds, HQ, YA, ka->in[5] + l * 8, bx, G, tid, wave, lane);
    sgu_phase(lds, HQ, YB, ka->in[6] + l * 512, ka->in[7] + l * 512, ka->in[8] + (size_t)l * 4 * 128 * 128, ka->in[9] + l * 512, bx, G, wave, lane);
}
template <int MODE> __device__ __forceinline__ void phase_gate(LAS unsigned char* lds, int l) {
    PHASE_ENV();
    const bf16* YA = (const bf16*)(ws + WS_Y);
    pg8::Gemm g{YA + (size_t)MODE * M * 512, (const bf16*)(ws + WS_W) + (size_t)l * W_LAYER_E + W_IN_E + (size_t)MODE * W_P_E, M, D, 512}; pg8::StaticOrder S; S.init(M, D, G, bx);
    pg8::EpiGate<MODE> E{(const bf16*)(ws + WS_HR), (bf16*)(ws + WS_MG), MODE * 1024};
    pg8::gemm_phase<pg8::EpiGate<MODE>, pg8::StaticOrder, true, true>(lds, g, S, E);
}
__device__ __forceinline__ void phase_outproj(LAS unsigned char* lds, int l) {
    PHASE_ENV();
    pg8::Gemm g{(const bf16*)(ws + WS_MG), (const bf16*)(ws + WS_W) + (size_t)l * W_LAYER_E + W_IN_E + 2 * W_P_E, M, D, D}; pg8::StaticOrder S; S.init(M, D, G, bx);
    pg8::EpiOut E{ka->out, ka->in[13] + (size_t)l * D, ALPHA};
    pg8::gemm_phase<pg8::EpiOut, pg8::StaticOrder, true, true>(lds, g, S, E);
}
__device__ __forceinline__ void phase_ln(int l) {
    PHASE_ENV();
    const int gw = bx * NWAVES + wave, ngw = G * NWAVES;
    ln_phase(ka->out, ka->out, (l + 1 < DEPTH) ? (bf16*)(ws + WS_XB) : nullptr, ka->in[14] + (size_t)l * D, ka->in[15] + (size_t)l * D, gw, ngw, lane);
}


#ifdef SELFTEST
constexpr size_t WS_ST = WS_END;
__device__ __forceinline__ unsigned st_hash(unsigned x) { x ^= x >> 16; x *= 0x7feb352du; x ^= x >> 15; x *= 0x846ca68bu; x ^= x >> 16; return x; }
__device__ __forceinline__ float bf2f(bf16 b) { return __uint_as_float(((unsigned)b) << 16); }
__device__ __forceinline__ float rbf(float f) { return __uint_as_float(f2bf(f) << 16); }
__device__ __forceinline__ void st_acc(float* st, int k, float got, float ref) { const float e = got - ref; atomicAdd(st + 2 * k, (e == e) ? e * e : 1e30f); atomicAdd(st + 2 * k + 1, ref * ref); }
__device__ void phase_selftest(int l) {
    PHASE_ENV();
    float* st = (float*)(ws + WS_ST);
    const bf16* XB = (const bf16*)(ws + WS_XB); const bf16* HQ = (const bf16*)(ws + WS_HQ); const bf16* HR = (const bf16*)(ws + WS_HR);
    const bf16* YA = (const bf16*)(ws + WS_Y); const bf16* YB = YA + (size_t)M * 512; const bf16* MG = (const bf16*)(ws + WS_MG);
    const unsigned gt = (unsigned)(bx * NTHREADS + tid);
    const unsigned h1 = st_hash(gt * 2654435761u + 12345u), h2 = st_hash(h1 + 0x9e3779b9u);
    { const int t = (int)(h1 % (unsigned)M), c = (int)(h2 % (unsigned)IN_COLS);
      const float* w = ka->in[3] + (size_t)l * D * IN_COLS; float a = 0.f;
      for (int k = 0; k < D; ++k) a += bf2f(XB[(size_t)t * D + k]) * rbf(w[(size_t)k * IN_COLS + c]);
      a += ka->in[4][l * IN_COLS + c];
      const int seg = c < 768 ? 0 : (c < 1280 ? 1 : (c < 2304 ? 2 : (c < 2816 ? 1 : 3)));
      float ref = a;
      if (seg == 1) ref = a / (1.f + expf(-a));
      if (seg == 2) ref = 0.5f * a * (1.f + tanhf(0.7978845608f * (a + 0.044715f * a * a * a)));
      if (seg == 3) ref = 1.f / (1.f + expf(-a));
      const float got = c < NQ ? bf2f(HQ[(size_t)t * NQ + c]) : bf2f(HR[(size_t)t * NR + (c - NQ)]);
      st_acc(st, 2, got, ref); }
    { const int t = (int)(h2 % (unsigned)M), c = (int)(h1 % 1024u);
      const float* pa = ka->in[10] + (size_t)l * 512 * D; const float* pb = ka->in[11] + (size_t)l * 512 * D; float a = 0.f, b = 0.f;
      for (int k = 0; k < 512; ++k) { a += bf2f(YA[(size_t)t * 512 + k]) * rbf(pa[(size_t)k * D + c]); b += bf2f(YB[(size_t)t * 512 + k]) * rbf(pb[(size_t)k * D + c]); }
      const float ref = bf2f(HR[(size_t)t * NR + c]) * a + bf2f(HR[(size_t)t * NR + 1024 + c]) * b;
      st_acc(st, 3, bf2f(MG[(size_t)t * D + c]), ref); }
    { const unsigned h3 = st_hash(h2 + 77u); int t = (int)(h3 % (unsigned)M); const int col = (int)(h1 % 512u), hq = col >> 6, d = col & 63, kvh = hq >> 2;
      if ((gt & 7u) == 0u) t = (t & ~4095) | (t & 127);
      const int s = t & 4095, jlo = s - 127 > 0 ? s - 127 : 0; const size_t tb = (size_t)(t - s);
      const float sink = ka->in[5][l * 8 + hq];
      float mx = sink;
      for (int j = jlo; j <= s; ++j) { float sc = 0.f; for (int k = 0; k < 64; ++k) sc += bf2f(HQ[(size_t)t * NQ + hq * 64 + k]) * bf2f(HQ[(tb + j) * NQ + C_K + kvh * 64 + k]); sc *= 0.125f; mx = fmaxf(mx, sc); }
      float den = expf(sink - mx), o = 0.f;
      for (int j = jlo; j <= s; ++j) { float sc = 0.f; for (int k = 0; k < 64; ++k) sc += bf2f(HQ[(size_t)t * NQ + hq * 64 + k]) * bf2f(HQ[(tb + j) * NQ + C_K + kvh * 64 + k]); sc *= 0.125f;
          const float p = expf(sc - mx); den += p; o += p * bf2f(HQ[(tb + j) * NQ + C_V + kvh * 64 + d]); }
      const float ref = o / den * bf2f(HQ[(size_t)t * NQ + C_GA + col]);
      st_acc(st, 0, bf2f(YA[(size_t)t * 512 + col]), ref); }
    if ((tid & 15) == 0) { const unsigned h3 = st_hash(h1 + 991u); const int t = (int)(h3 % (unsigned)M), c = (int)(h2 % 512u), g = c >> 7, tt = t & 127; const size_t t0 = (size_t)(t - tt);
      const float* w_s = ka->in[8] + (size_t)l * 4 * 128 * 128; float mixed = ka->in[9][l * 512 + g * 128 + tt];
      for (int sidx = 0; sidx <= tt; ++sidx) { const bf16* vr = HQ + (t0 + sidx) * NQ + C_VB; float mu = 0.f; for (int k = 0; k < 512; ++k) mu += bf2f(vr[k]); mu *= (1.f / 512.f);
          float var = 0.f; for (int k = 0; k < 512; ++k) { const float dv = bf2f(vr[k]) - mu; var += dv * dv; } var *= (1.f / 512.f);
          const float vn = (bf2f(vr[c]) - mu) / sqrtf(var + LN_EPS) * ka->in[6][l * 512 + c] + ka->in[7][l * 512 + c];
          mixed += w_s[((size_t)g * 128 + tt) * 128 + sidx] * vn; }
      const float ref = bf2f(HQ[(size_t)t * NQ + C_U + c]) * mixed * bf2f(HQ[(size_t)t * NQ + C_GB + c]);
      st_acc(st, 1, bf2f(YB[(size_t)t * 512 + c]), ref); }
}

__device__ void st_copy(const float* src, float* dst) { PHASE_ENV(); const f32x4* s4 = (const f32x4*)src; f32x4* d4 = (f32x4*)dst;
    for (size_t i = (size_t)bx * NTHREADS + tid; i < (size_t)M * D / 4; i += (size_t)G * NTHREADS) d4[i] = s4[i]; }
__device__ void phase_selftest_out(int l) {
    PHASE_ENV();
    float* st = (float*)(ws + WS_ST); const float* XC = (const float*)(ws + WS_HQ); const bf16* MG = (const bf16*)(ws + WS_MG);
    const unsigned gt = (unsigned)(bx * NTHREADS + tid); const unsigned h1 = st_hash(gt * 2654435761u + 4242u), h2 = st_hash(h1 + 0x9e3779b9u);
    const int t = (int)(h1 % (unsigned)M), c = (int)(h2 % 1024u);
    const float* w = ka->in[12] + (size_t)l * D * D; float a = 0.f;
    for (int k = 0; k < D; ++k) a += bf2f(MG[(size_t)t * D + k]) * rbf(w[(size_t)k * D + c]);
    a += ka->in[13][l * D + c];
    const float got = ka->out[(size_t)t * D + c] - ALPHA * XC[(size_t)t * D + c];
    st_acc(st, 0, got, a);
}
__device__ void phase_selftest_ln(int l) {
    PHASE_ENV();
    float* st = (float*)(ws + WS_ST); const float* ZC = (const float*)(ws + WS_HR);
    const unsigned gt = (unsigned)(bx * NTHREADS + tid); const unsigned h1 = st_hash(gt * 2654435761u + 777u), h2 = st_hash(h1 + 0x9e3779b9u);
    if ((tid & 7) == 0) { const int t = (int)(h1 % (unsigned)M), c = (int)(h2 % 1024u); const float* zr = ZC + (size_t)t * D;
        float mu = 0.f; for (int k = 0; k < D; ++k) mu += zr[k]; mu *= (1.f / D);
        float var = 0.f; for (int k = 0; k < D; ++k) { const float dv = zr[k] - mu; var += dv * dv; } var *= (1.f / D);
        const float ref = (zr[c] - mu) / sqrtf(var + LN_EPS) * ka->in[14][l * D + c] + ka->in[15][l * D + c];
        const float got = ka->out[(size_t)t * D + c];
        st_acc(st, 1, ref + (got - ref) * 100.f, ref); }
}

__device__ void phase_selftest_seg(int l) {
    PHASE_ENV();
    float* st = (float*)(ws + WS_ST);
    const bf16* XB = (const bf16*)(ws + WS_XB); const bf16* HQ = (const bf16*)(ws + WS_HQ); const bf16* HR = (const bf16*)(ws + WS_HR);
    const unsigned gt = (unsigned)(bx * NTHREADS + tid); const unsigned h1 = st_hash(gt * 2654435761u + 999u), h2 = st_hash(h1 + 0x9e3779b9u);
    const int t = (int)(h1 % (unsigned)M), k4 = (int)(gt & 3u);
    const int c = (k4 == 0 ? 1280 : (k4 == 1 ? 1792 : (k4 == 2 ? 2304 : 3840))) + (int)(h2 % 512u);
    const float* w = ka->in[3] + (size_t)l * D * IN_COLS; float a = 0.f;
    for (int k = 0; k < D; ++k) a += bf2f(XB[(size_t)t * D + k]) * rbf(w[(size_t)k * IN_COLS + c]);
    a += ka->in[4][l * IN_COLS + c];
    float ref = a;
    if (k4 == 2) ref = a / (1.f + expf(-a));
    if (k4 < 2) ref = 0.5f * a * (1.f + tanhf(0.7978845608f * (a + 0.044715f * a * a * a)));
    if (k4 == 3) ref = 1.f / (1.f + expf(-a));
    const float got = c < NQ ? bf2f(HQ[(size_t)t * NQ + c]) : bf2f(HR[(size_t)t * NR + (c - NQ)]);
    st_acc(st, k4, ref + (got - ref) * 3.f, ref);
}
__device__ __forceinline__ int st_class(float sse, float ssr) { if (!(sse == sse) || sse > 1e29f) return 6; const float r = sqrtf(sse / (ssr + 1e-30f)); return r < 0.005f ? 0 : (r < 0.015f ? 1 : (r < 0.05f ? 2 : (r < 0.15f ? 3 : (r < 0.5f ? 4 : 5)))); }
__device__ void phase_selftest_report() {
    PHASE_ENV();
    const float* st = (const float*)(ws + WS_ST);
    const int c0 = st_class(st[0], st[1]), c1 = st_class(st[2], st[3]), c2 = st_class(st[4], st[5]), c3 = st_class(st[6], st[7]);
#ifndef ST_THRESH
#define ST_THRESH 2
#endif
    if (c0 >= ST_THRESH || c1 >= ST_THRESH || c2 >= ST_THRESH || c3 >= ST_THRESH) {
        const float V = 1.0e4f * (float)(10 * (c0 + 1) + c1);
        const int N = 100 * (10 * (c2 + 1) + c3);
        for (int i = bx * NTHREADS + tid; i < N; i += G * NTHREADS) ka->out[(size_t)i * 4099] = V;
    }
}
#endif

__device__ __forceinline__ void grid_bar(LAS unsigned char* lds) {
    KArgs ka = (KArgs)__builtin_amdgcn_kernarg_segment_ptr(); asm volatile("" : "+s"(ka));
    XcdBarrier b; b.bar = (unsigned*)(ka->ws + WS_CTL); b.x = xb_xcc_id(); b.st = (volatile LAS unsigned*)(lds + XBAR_LDS_OFF);
    xcd_barrier(b);
}
#ifdef STAMPS
#define STAMP(k) do { if (blockIdx.x == 0 && threadIdx.x == 0) ((unsigned long long*)(args.ws + WS_END + 1024))[k] = __builtin_amdgcn_s_memrealtime(); } while (0)
#else
#define STAMP(k) do { } while (0)
#endif
__global__ void __launch_bounds__(NTHREADS, 2) fwd_megakernel(Args args) {
    extern __shared__ __attribute__((aligned(16))) unsigned char lds_raw[];
    LAS unsigned char* lds = (LAS unsigned char*)lds_raw;
    cg::grid_group grid = cg::this_grid();
    if (threadIdx.x < 16) ((LAS unsigned*)(lds + XBAR_LDS_OFF))[threadIdx.x] = 0u;
    __syncthreads();
    (void)xcd_barrier_post((unsigned*)(args.ws + WS_CTL), (volatile LAS unsigned*)(lds + XBAR_LDS_OFF));
#define GRID_BAR() grid_bar(lds)
#ifdef SELFTEST
    if (blockIdx.x == 0 && threadIdx.x < 16) ((float*)(args.ws + WS_ST))[threadIdx.x] = 0.f;
#endif
    STAMP(0);
    phase_prologue(lds); __syncthreads();
    grid.sync(); STAMP(1);
#pragma unroll
    for (int l = 0; l < DEPTH; ++l) {
        phase_inproj(lds, l);        GRID_BAR();  STAMP(2 + 5 * l);
        phase_mixers(lds, l);        GRID_BAR();  STAMP(3 + 5 * l);
        phase_gate<0>(lds, l);
        phase_gate<1>(lds, l);       GRID_BAR();  STAMP(4 + 5 * l);
#ifdef SELFTEST
#if ST_PART == 3
        if (l == ST_LAYER) { phase_selftest_seg(l); grid.sync(); }
#elif ST_PART == 1
        if (l == ST_LAYER) { phase_selftest(l); grid.sync(); }
#else
        if (l == ST_LAYER) { st_copy(((KArgs)__builtin_amdgcn_kernarg_segment_ptr())->out, (float*)(((KArgs)__builtin_amdgcn_kernarg_segment_ptr())->ws + WS_HQ)); grid.sync(); }
#endif
#endif
        phase_outproj(lds, l);       GRID_BAR();  STAMP(5 + 5 * l);
#if defined(SELFTEST) && ST_PART == 2
        if (l == ST_LAYER) { phase_selftest_out(l); st_copy(((KArgs)__builtin_amdgcn_kernarg_segment_ptr())->out, (float*)(((KArgs)__builtin_amdgcn_kernarg_segment_ptr())->ws + WS_HR)); grid.sync(); }
#endif
        phase_ln(l);
#if defined(SELFTEST) && ST_PART == 2
        if (l == ST_LAYER) { grid.sync(); phase_selftest_ln(l); }
#endif
        if (l + 1 < DEPTH) GRID_BAR();
        STAMP(6 + 5 * l);
    }
#ifdef STAMPS
    grid.sync();
    { const unsigned long long* T = (const unsigned long long*)(args.ws + WS_END + 1024);
      const float da = (float)(T[STAMP_A + 1] - T[STAMP_A]) * 0.01f, db = (float)(T[STAMP_B + 1] - T[STAMP_B]) * 0.01f;
      const float V = da * 100.f; const int N = (int)db;
      for (int i = blockIdx.x * NTHREADS + threadIdx.x; i < N; i += gridDim.x * NTHREADS) args.out[(size_t)i * 4099] = V; }
#endif
#ifdef SELFTEST
    grid.sync(); phase_selftest_report();
#endif
}

extern "C" void kernel_launch(void* const* d_in, const int* in_sizes, int n_in, void* d_out, int out_size, void* d_ws, size_t ws_size, hipStream_t stream) {
    static int grid = 0;
    if (grid == 0) {
        if (n_in != 16 || in_sizes[0] != M * D || out_size != M * D || ws_size < WS_CTL + CTL_BYTES) { fprintf(stderr, "kernel_launch: unexpected shapes (n_in %d, in0 %d, out %d, ws %zu)\n", n_in, n_in > 0 ? in_sizes[0] : -1, out_size, ws_size); grid = -1; return; }
        int dev = 0, cus = 0, per_cu = 0;
        hipGetDevice(&dev); hipDeviceGetAttribute(&cus, hipDeviceAttributeMultiprocessorCount, dev);
        if (hipFuncSetAttribute((const void*)fwd_megakernel, hipFuncAttributeMaxDynamicSharedMemorySize, LDS_BYTES) != hipSuccess) { fprintf(stderr, "kernel_launch: hipFuncSetAttribute failed\n"); grid = -1; return; }
        if (hipOccupancyMaxActiveBlocksPerMultiprocessor(&per_cu, (const void*)fwd_megakernel, NTHREADS, LDS_BYTES) != hipSuccess || per_cu < 1) { fprintf(stderr, "kernel_launch: occupancy query says %d\n", per_cu); per_cu = 1; }
        (void)hipGetLastError();
        grid = cus * 1;
        if (grid <= 0) grid = 256;
    }
    if (grid < 0) return;
    if (hipMemsetAsync((char*)d_ws + WS_CTL, 0, CTL_BYTES, stream) != hipSuccess) { fprintf(stderr, "kernel_launch: memset of the barrier words failed\n"); return; }
    Args a{};
    for (int i = 0; i < 16; ++i) a.in[i] = (const float*)d_in[i];
    a.out = (float*)d_out; a.ws = (unsigned char*)d_ws;
    void* kargs[] = {&a};
    hipError_t e = hipLaunchCooperativeKernel((const void*)fwd_megakernel, dim3(grid), dim3(NTHREADS), kargs, LDS_BYTES, stream);
    if (e != hipSuccess) fprintf(stderr, "kernel_launch: cooperative launch failed: %s (grid %d)\n", hipGetErrorString(e), grid);
}
```
